# Optimizing an MI355X kernel written in HIP

```python
import jax, jax.numpy as jnp
from jax import lax
import numpy as np

D_MODEL = 1024
BATCH = 2
SEQ = 8192
DEPTH = 2

N_MIXERS = 2
S5_GROUP = 16
S5_GROUPS = D_MODEL // S5_GROUP
S5_STATE = 64
S5_CHUNK = 128
DT_MIN = 1e-3
DT_MAX = 1e-1
FOX_HEADS = 16
FOX_HEAD_DIM = D_MODEL // FOX_HEADS
Q_BLOCK = 128
FGATE_B_LO = 2.0
FGATE_B_HI = 6.0
D_FF = 2816
CONV_W = 3
EPS = 1e-6
N_S5 = (DEPTH + 1) // 2
N_FOX = DEPTH // 2

kernel_name = "hybrid_s5_fox_convffn_adaln"


def rmsnorm(x, g):
    x32 = x.astype(jnp.float32)
    y = x32 * lax.rsqrt(jnp.mean(x32 * x32, axis=-1, keepdims=True) + EPS)
    return (y * g.astype(jnp.float32)).astype(x.dtype)


def adaln_params(c, w, b):
    mod = jax.nn.silu(c) @ w + b
    shift, scale, gate = jnp.split(mod, 3, axis=-1)
    return shift[:, None, :], scale[:, None, :], gate[:, None, :]


def modulate(x, g, shift, scale):
    return rmsnorm(x, g) * (1.0 + scale) + shift


def s5_mixer(h, w_in, lam_re, lam_im, log_dt, b_re, b_im, c_re, c_im, d_skip, w_glu, w_out):
    f32 = jnp.float32
    Bsz, S, _ = h.shape
    u = h @ w_in
    ug = u.reshape(Bsz, S, S5_GROUPS, S5_GROUP)
    lre = lam_re.astype(f32)
    lim = lam_im.astype(f32)
    dt = jnp.exp(log_dt.astype(f32))[:, None]
    mag = jnp.exp(lre * dt)
    lb_re = mag * jnp.cos(lim * dt)
    lb_im = mag * jnp.sin(lim * dt)
    num_re = lb_re - 1.0
    den = lre * lre + lim * lim
    k_re = (num_re * lre + lb_im * lim) / den
    k_im = (lb_im * lre - num_re * lim) / den
    br = b_re.astype(f32)
    bi = b_im.astype(f32)
    bb_re = k_re[..., None] * br - k_im[..., None] * bi
    bb_im = k_re[..., None] * bi + k_im[..., None] * br
    cr = c_re.astype(f32)
    ci = c_im.astype(f32)

    def combine(left, right):
        a1r, a1i, b1r, b1i = left
        a2r, a2i, b2r, b2i = right
        ar = a2r * a1r - a2i * a1i
        ai = a2r * a1i + a2i * a1r
        b_r = a2r * b1r - a2i * b1i + b2r
        b_i = a2r * b1i + a2i * b1r + b2i
        return ar, ai, b_r, b_i

    def chunk_step(carry, u_c):
        h_re, h_im = carry
        bu_re = jnp.einsum('blgc,gpc->blgp', u_c, bb_re)
        bu_im = jnp.einsum('blgc,gpc->blgp', u_c, bb_im)
        bu_re = bu_re.at[:, 0].add(lb_re * h_re - lb_im * h_im)
        bu_im = bu_im.at[:, 0].add(lb_re * h_im + lb_im * h_re)
        a_re = jnp.broadcast_to(lb_re, bu_re.shape)
        a_im = jnp.broadcast_to(lb_im, bu_im.shape)
        _, _, hs_re, hs_im = lax.associative_scan(combine, (a_re, a_im, bu_re, bu_im), axis=1)
        y = jnp.einsum('blgp,gcp->blgc', hs_re, cr) - jnp.einsum('blgp,gcp->blgc', hs_im, ci)
        return (hs_re[:, -1], hs_im[:, -1]), y

    n_chunks = S // S5_CHUNK
    u_chunks = ug.reshape(Bsz, n_chunks, S5_CHUNK, S5_GROUPS, S5_GROUP).transpose(1, 0, 2, 3, 4)
    h0 = (jnp.zeros((Bsz, S5_GROUPS, S5_STATE), f32), jnp.zeros((Bsz, S5_GROUPS, S5_STATE), f32))
    _, ys = lax.scan(chunk_step, h0, u_chunks)
    y = ys.transpose(1, 0, 2, 3, 4).reshape(Bsz, S, D_MODEL)
    y = y + d_skip.astype(f32) * u.astype(f32)
    y = jax.nn.gelu(y)
    y = y * jax.nn.sigmoid(y @ w_glu.astype(f32))
    return (y @ w_out.astype(f32)).astype(h.dtype)


def fox_mixer(h, w_in, b_f, w_out):
    f32 = jnp.float32
    Bsz, S, _ = h.shape
    proj = h @ w_in
    q = proj[..., :D_MODEL].reshape(Bsz, S, FOX_HEADS, FOX_HEAD_DIM) * (FOX_HEAD_DIM ** -0.5)
    k = proj[..., D_MODEL:2 * D_MODEL].reshape(Bsz, S, FOX_HEADS, FOX_HEAD_DIM)
    v = proj[..., 2 * D_MODEL:3 * D_MODEL].reshape(Bsz, S, FOX_HEADS, FOX_HEAD_DIM)
    f_logit = proj[..., 3 * D_MODEL:]
    log_f = jax.nn.log_sigmoid((f_logit + b_f).astype(f32))
    F = lax.cumsum(log_f, axis=1).transpose(0, 2, 1)
    n_q = S // Q_BLOCK
    q_blocks = q.reshape(Bsz, n_q, Q_BLOCK, FOX_HEADS, FOX_HEAD_DIM).transpose(1, 0, 3, 2, 4)
    F_blocks = F.reshape(Bsz, FOX_HEADS, n_q, Q_BLOCK).transpose(2, 0, 1, 3)
    k_pos = jnp.arange(S)

    def attend_block(args):
        qi, q_blk, Fq = args
        s = jnp.einsum('bhqd,bshd->bhqs', q_blk, k).astype(f32)
        s = s + Fq[..., None] - F[:, :, None, :]
        q_pos = qi * Q_BLOCK + jnp.arange(Q_BLOCK)
        causal = k_pos[None, :] <= q_pos[:, None]
        s = jnp.where(causal, s, -jnp.inf)
        p = jax.nn.softmax(s, axis=-1)
        return jnp.einsum('bhqs,bshd->bqhd', p.astype(v.dtype), v)

    o = lax.map(attend_block, (jnp.arange(n_q), q_blocks, F_blocks))
    o = o.transpose(1, 0, 2, 3, 4).reshape(Bsz, S, D_MODEL)
    return o @ w_out


def conv_ffn(h, w_up, conv_w, conv_b, w_down):
    up = h @ w_up
    a, b = jnp.split(up, 2, axis=-1)
    S = a.shape[1]
    ap = jnp.pad(a, ((0, 0), (CONV_W - 1, 0), (0, 0)))
    a_conv = conv_b
    for i in range(CONV_W):
        a_conv = a_conv + ap[:, i:i + S] * conv_w[i]
    return (jax.nn.silu(a_conv) * b) @ w_down


def setup_inputs(seed: int = 0) -> dict:
    key = jax.random.key(seed)
    ks = jax.random.split(key, 32)
    f32 = jnp.float32
    D, G, P, Cg, H, F = D_MODEL, S5_GROUPS, S5_STATE, S5_GROUP, FOX_HEADS, D_FF
    nrm = lambda k, shape, s: jax.random.normal(k, shape, f32) * s
    x = nrm(ks[0], (BATCH, SEQ, D), 1.0)
    c = nrm(ks[1], (BATCH, D), 1.0)
    norm_g = 1.0 + nrm(ks[2], (DEPTH, 2, D), 0.01)
    ada_w = nrm(ks[3], (DEPTH, 2, D, 3 * D), 0.5 * D ** -0.5)
    ada_b = nrm(ks[4], (DEPTH, 2, 3 * D), 0.01)
    s5_w_in = nrm(ks[5], (N_S5, D, D), D ** -0.5)
    s5_lam_re = -0.5 + nrm(ks[6], (N_S5, G, P), 0.01)
    s5_lam_im = jnp.pi * jnp.arange(P, dtype=f32) + nrm(ks[7], (N_S5, G, P), 0.01)
    s5_log_dt = jax.random.uniform(ks[8], (N_S5, G), f32, np.log(DT_MIN), np.log(DT_MAX))
    s5_b_re = nrm(ks[9], (N_S5, G, P, Cg), (2.0 * Cg) ** -0.5)
    s5_b_im = nrm(ks[10], (N_S5, G, P, Cg), (2.0 * Cg) ** -0.5)
    s5_c_re = nrm(ks[11], (N_S5, G, Cg, P), (2.0 * P) ** -0.5)
    s5_c_im = nrm(ks[12], (N_S5, G, Cg, P), (2.0 * P) ** -0.5)
    s5_d = nrm(ks[13], (N_S5, D), 1.0)
    s5_w_glu = nrm(ks[14], (N_S5, D, D), D ** -0.5)
    s5_w_out = nrm(ks[15], (N_S5, D, D), D ** -0.5)
    fox_w_in = nrm(ks[16], (N_FOX, D, 3 * D + H), D ** -0.5)
    fox_b_f = jax.random.uniform(ks[17], (N_FOX, H), f32, FGATE_B_LO, FGATE_B_HI)
    fox_w_out = nrm(ks[18], (N_FOX, D, D), D ** -0.5)
    ffn_w_up = nrm(ks[19], (DEPTH, D, 2 * F), D ** -0.5)
    ffn_conv_w = nrm(ks[20], (DEPTH, CONV_W, F), CONV_W ** -0.5)
    ffn_conv_b = nrm(ks[21], (DEPTH, F), 0.01)
    ffn_w_down = nrm(ks[22], (DEPTH, F, D), F ** -0.5)
    final_g = 1.0 + nrm(ks[23], (D,), 0.01)
    return {"x": x, "c": c, "norm_g": norm_g, "ada_w": ada_w, "ada_b": ada_b,
            "s5_w_in": s5_w_in, "s5_lam_re": s5_lam_re, "s5_lam_im": s5_lam_im,
            "s5_log_dt": s5_log_dt, "s5_b_re": s5_b_re, "s5_b_im": s5_b_im,
            "s5_c_re": s5_c_re, "s5_c_im": s5_c_im, "s5_d": s5_d,
            "s5_w_glu": s5_w_glu, "s5_w_out": s5_w_out,
            "fox_w_in": fox_w_in, "fox_b_f": fox_b_f, "fox_w_out": fox_w_out,
            "ffn_w_up": ffn_w_up, "ffn_conv_w": ffn_conv_w, "ffn_conv_b": ffn_conv_b,
            "ffn_w_down": ffn_w_down, "final_g": final_g}


def reference(x, c, norm_g, ada_w, ada_b,
              s5_w_in, s5_lam_re, s5_lam_im, s5_log_dt, s5_b_re, s5_b_im,
              s5_c_re, s5_c_im, s5_d, s5_w_glu, s5_w_out,
              fox_w_in, fox_b_f, fox_w_out,
              ffn_w_up, ffn_conv_w, ffn_conv_b, ffn_w_down, final_g):
    h = x
    for i in range(DEPTH):
        j = i // N_MIXERS
        shift, scale, gate = adaln_params(c, ada_w[i, 0], ada_b[i, 0])
        hn = modulate(h, norm_g[i, 0], shift, scale)
        if i % N_MIXERS == 0:
            m = s5_mixer(hn, s5_w_in[j], s5_lam_re[j], s5_lam_im[j], s5_log_dt[j],
                         s5_b_re[j], s5_b_im[j], s5_c_re[j], s5_c_im[j], s5_d[j],
                         s5_w_glu[j], s5_w_out[j])
        else:
            m = fox_mixer(hn, fox_w_in[j], fox_b_f[j], fox_w_out[j])
        h = (h + gate * m).astype(x.dtype)
        shift, scale, gate = adaln_params(c, ada_w[i, 1], ada_b[i, 1])
        hn = modulate(h, norm_g[i, 1], shift, scale)
        f = conv_ffn(hn, ffn_w_up[i], ffn_conv_w[i], ffn_conv_b[i], ffn_w_down[i])
        h = (h + gate * f).astype(x.dtype)
    return rmsnorm(h, final_g)
```

```cpp
#include <hip/hip_runtime.h>
#include <hip/hip_cooperative_groups.h>
#include <cstdio>
#include <cstdint>
__device__ __forceinline__ int opaque_tid() { int t; asm volatile("v_mov_b32 %0, %1" : "=v"(t) : "v"((int)threadIdx.x)); return t; }
namespace pg8 {
#define PG8_LAS __attribute__((address_space(3)))
typedef unsigned short bf16_t;
typedef short bf16x8 __attribute__((ext_vector_type(8)));
typedef float f32x4 __attribute__((ext_vector_type(4)));
typedef unsigned u32x4 __attribute__((ext_vector_type(4)));
constexpr int BM = 256, BK = 64, HALF = 128, HTB = HALF * BK * 2  , STAGE_BYTES = 8 * HTB, NXCD = 8, WGM = 8;

__host__ __device__ __forceinline__ int lds_byte(int r, int c) { const int st = (r >> 4) * 2 + (c >> 5), rr = r & 15, cc = c & 31, ob = rr * 64 + cc * 2; return st * 1024 + (ob ^ (((ob >> 9) & 1) << 5)); }
__host__ __device__ __forceinline__ void stage_rc(int b, int& R, int& C) { const int st = b / 1024, sb = b % 1024, swz = sb ^ (((sb >> 9) & 1) << 5); R = (st >> 1) * 16 + swz / 64; C = (st & 1) * 32 + (swz % 64) / 2; }
__host__ __device__ __forceinline__ int perm32(int rho) { const int n = rho >> 4, i = rho & 15; return 8 * (i >> 2) + 4 * n + (i & 3); }

struct Unit { int pm, pn; };
struct Gemm { const bf16_t* A; const bf16_t* Bt; int M, N, K, lda; };

struct StaticOrder {
    int nM, nN, nwg, G, c;
    __host__ __device__ void init(int M, int N, int G_, int c_) { nM = M / BM; nN = N / BM; nwg = nM * nN; G = G_; c = c_; }
    __host__ __device__ bool next(int i, Unit& u) const {
        const long L = (long)i * G + c; if (L >= nwg) return false;
        int wgid = (int)L; { const int q = nwg / NXCD, r = nwg % NXCD, xcd = wgid % NXCD, off = wgid / NXCD; wgid = (xcd < r ? xcd * (q + 1) : r * (q + 1) + (xcd - r) * q) + off; }
        const int nig = WGM * nN, gid = wgid / nig, fm = gid * WGM, gsz = (nM - fm) < WGM ? (nM - fm) : WGM;
        u.pm = fm + ((wgid % nig) % gsz); u.pn = (wgid % nig) / gsz; return true;
    }
    __device__ __forceinline__ void a_ready(const Unit&) const {}
    __device__ __forceinline__ void done(const Unit&) const {}
};

__device__ __forceinline__ unsigned cvt_pk_bf16(float lo, float hi) { unsigned r; asm volatile("v_cvt_pk_bf16_f32 %0, %1, %2" : "=v"(r) : "v"(lo), "v"(hi)); return r; }
typedef float f32x2 __attribute__((ext_vector_type(2)));
__device__ __forceinline__ f32x2 gelu_pk(f32x2 v) {
    const f32x2 av = __builtin_elementwise_abs(v), d = av * 0.2316418882f + 1.0f;
    f32x2 t; t.x = __builtin_amdgcn_rcpf(d.x); t.y = __builtin_amdgcn_rcpf(d.y);
    f32x2 q = t * 0.5307027145f + (-0.7265760135f); q = q * t + 0.7107068705f; q = q * t + (-0.142248368f); q = q * t + 0.127414796f; q = q * t;
    const f32x2 s = (v * v) * (-0.72134752044f);
    f32x2 e; e.x = __builtin_amdgcn_exp2f(s.x); e.y = __builtin_amdgcn_exp2f(s.y);
    const f32x2 m = v * (q * e), r = v - m;
    f32x2 o; o.x = v.x < 0.f ? m.x : r.x; o.y = v.y < 0.f ? m.y : r.y; return o;
}

template <int ACT  > struct EpiBf16 {
    static constexpr bool PERM = true, AFTER_DRAIN = false, APERM = false; static_assert(ACT == 0 || ACT == 1, "EpiBf16: ACT is 0 (none) or 1 (gelu_pk)");
    bf16_t* O; int ldc; const float* bias; int split_cols; size_t split_stride; float scale0;
    __device__ __forceinline__ void operator()(const f32x4 (&acc)[2][2][4][2], const Unit& u, int wr, int wc, int fr, int fq) const {
        const int row0 = u.pm * BM + wr * 64 + fr; int colt = u.pn * BM; bf16_t* base = O;
        float sc = 1.f; if (split_cols) { const int t = colt / split_cols; base += (size_t)t * split_stride; colt -= t * split_cols; if (t == 0) sc = scale0; }
        const int col0 = colt + wc * 32 + 8 * fq, bcol0 = u.pn * BM + wc * 32 + 8 * fq;
        f32x4 bv[2][2];
#pragma unroll
        for (int bj = 0; bj < 2; ++bj)
#pragma unroll
            for (int n = 0; n < 2; ++n) bv[bj][n] = bias ? *(const f32x4*)(bias + bcol0 + bj * HALF + 4 * n) : (f32x4){0.f, 0.f, 0.f, 0.f};
#pragma unroll
        for (int ai = 0; ai < 2; ++ai)
#pragma unroll
            for (int m = 0; m < 4; ++m) { bf16_t* rowp = base + (size_t)(row0 + ai * HALF + m * 16) * ldc + col0;
#pragma unroll
                for (int bj = 0; bj < 2; ++bj) { f32x4 v0 = acc[ai][bj][m][0] + bv[bj][0], v1 = acc[ai][bj][m][1] + bv[bj][1];
                    if (ACT == 1) { f32x2 a = gelu_pk((f32x2){v0[0], v0[1]}), b = gelu_pk((f32x2){v0[2], v0[3]}), c = gelu_pk((f32x2){v1[0], v1[1]}), d = gelu_pk((f32x2){v1[2], v1[3]});
                        v0 = (f32x4){a.x, a.y, b.x, b.y}; v1 = (f32x4){c.x, c.y, d.x, d.y}; }
                    v0 = v0 * sc; v1 = v1 * sc; u32x4 w; w.x = cvt_pk_bf16(v0[0], v0[1]); w.y = cvt_pk_bf16(v0[2], v0[3]); w.z = cvt_pk_bf16(v1[0], v1[1]); w.w = cvt_pk_bf16(v1[2], v1[3]);
                    *(u32x4*)(rowp + bj * HALF) = w; } }
    }
};
__device__ __forceinline__ float bf_lo(unsigned w) { return __uint_as_float(w << 16); }
__device__ __forceinline__ float bf_hi(unsigned w) { return __uint_as_float(w & 0xffff0000u); }
__device__ __forceinline__ float sigmoid_f(float v) { return __builtin_amdgcn_rcpf(1.0f + __expf(-v)); }
__device__ __forceinline__ float rstd_of(const float* p) { const float s = *p; return 1.0f / sqrtf(s * (1.0f / 1024.0f) + 1e-6f); }
struct EpiQkvF {
    static constexpr bool PERM = true, AFTER_DRAIN = false, APERM = false;
    bf16_t* O; size_t split_stride; float scale0; const float* bfg; float* nlf; const float* rs; const float* sw;
    __device__ __forceinline__ void operator()(const f32x4 (&acc)[2][2][4][2], const Unit& u, int wr, int wc, int fr, int fq) const {
        float rstd[2][4];
#pragma unroll
        for (int ai = 0; ai < 2; ++ai)
#pragma unroll
            for (int m = 0; m < 4; ++m) rstd[ai][m] = rstd_of(rs + u.pm * BM + ai * HALF + wr * 64 + m * 16 + fr);
        const float* swp = sw + (size_t)(u.pm >> 5) * 3328 + u.pn * BM + wc * 32 + 8 * fq;
        if (u.pn == 12) {
            if (wc == 0 && fq < 2) {
#pragma unroll
                for (int ai = 0; ai < 2; ++ai)
#pragma unroll
                    for (int m = 0; m < 4; ++m) { const int row = u.pm * BM + ai * HALF + wr * 64 + m * 16 + fr; const int b = row >> 13, t = row & 8191;
#pragma unroll
                        for (int n = 0; n < 2; ++n)
#pragma unroll
                            for (int j = 0; j < 4; ++j) { const int h = 8 * fq + 4 * n + j; const float x = acc[ai][0][m][n][j] * rstd[ai][m] + swp[4 * n + j] + bfg[h];
                                const float e = __expf(-x); const float sp = (e < 1e-3f) ? e * (1.0f - e * (0.5f - e * 0.33333333f)) : __logf(1.0f + e);
                                nlf[(size_t)(b * 16 + h) * 8192 + t] = sp * 1.4426950408889634f; } }
            }
            return;
        }
        const int row0 = u.pm * BM + wr * 64 + fr; const int t = u.pn >> 2; bf16_t* base = O + (size_t)t * split_stride; const int colt = (u.pn & 3) * BM;
        const float sc = (t == 0) ? scale0 : 1.0f;
        const int col0 = colt + wc * 32 + 8 * fq;
#pragma unroll
        for (int ai = 0; ai < 2; ++ai)
#pragma unroll
            for (int m = 0; m < 4; ++m) { bf16_t* rowp = base + (size_t)(row0 + ai * HALF + m * 16) * 1024 + col0;
#pragma unroll
                for (int bj = 0; bj < 2; ++bj) { const f32x4 s0 = *(const f32x4*)(swp + bj * HALF), s1 = *(const f32x4*)(swp + bj * HALF + 4);
                    f32x4 v0 = (acc[ai][bj][m][0] * rstd[ai][m] + s0) * sc, v1 = (acc[ai][bj][m][1] * rstd[ai][m] + s1) * sc;
                    u32x4 w; w.x = cvt_pk_bf16(v0[0], v0[1]); w.y = cvt_pk_bf16(v0[2], v0[3]); w.z = cvt_pk_bf16(v1[0], v1[1]); w.w = cvt_pk_bf16(v1[2], v1[3]);
                    *(u32x4*)(rowp + bj * HALF) = w; } }
    }
};
struct EpiGlu {
    static constexpr bool PERM = true, AFTER_DRAIN = false, APERM = false;
    const bf16_t* Y; bf16_t* Z; int ldc;
    __device__ __forceinline__ void operator()(const f32x4 (&acc)[2][2][4][2], const Unit& u, int wr, int wc, int fr, int fq) const {
        const int row0 = u.pm * BM + wr * 64 + fr, col0 = u.pn * BM + wc * 32 + 8 * fq;
#pragma unroll
        for (int ai = 0; ai < 2; ++ai)
#pragma unroll
            for (int m = 0; m < 4; ++m) { const size_t off = (size_t)(row0 + ai * HALF + m * 16) * ldc + col0;
#pragma unroll
                for (int bj = 0; bj < 2; ++bj) { const u32x4 yv = *(const u32x4*)(Y + off + bj * HALF); const f32x4 v0 = acc[ai][bj][m][0], v1 = acc[ai][bj][m][1];
                    u32x4 w;
                    w.x = cvt_pk_bf16(bf_lo(yv.x) * sigmoid_f(v0[0]), bf_hi(yv.x) * sigmoid_f(v0[1]));
                    w.y = cvt_pk_bf16(bf_lo(yv.y) * sigmoid_f(v0[2]), bf_hi(yv.y) * sigmoid_f(v0[3]));
                    w.z = cvt_pk_bf16(bf_lo(yv.z) * sigmoid_f(v1[0]), bf_hi(yv.z) * sigmoid_f(v1[1]));
                    w.w = cvt_pk_bf16(bf_lo(yv.w) * sigmoid_f(v1[2]), bf_hi(yv.w) * sigmoid_f(v1[3]));
                    *(u32x4*)(Z + off + bj * HALF) = w; } }
    }
};
__device__ __forceinline__ f32x4 dpp_ror1(f32x4 v) { f32x4 r;
#pragma unroll
    for (int j = 0; j < 4; ++j) r[j] = __int_as_float(__builtin_amdgcn_update_dpp(0, __float_as_int(v[j]), 0x121, 0xF, 0xF, true));
    return r; }
__device__ __forceinline__ f32x4 silu4_mul(f32x4 c, f32x4 b) { f32x4 r;
#pragma unroll
    for (int j = 0; j < 4; ++j) r[j] = c[j] * __builtin_amdgcn_rcpf(1.0f + __expf(-c[j])) * b[j];
    return r; }
struct EpiConvGate {
    static constexpr bool PERM = true, AFTER_DRAIN = false, APERM = true;
    bf16_t* G; float* fixa; float* fixb; float* halo; const float* cw; const float* cb; int FFn; const float* rs; const float* sw;
    __device__ __forceinline__ void operator()(const f32x4 (&acc)[2][2][4][2], const Unit& u, int wr, int wc, int fr, int fq) const {
        typedef unsigned u32x2 __attribute__((ext_vector_type(2)));
        const int f0 = u.pn * HALF + wc * 32 + 8 * fq;
        float rstd[2][4];
#pragma unroll
        for (int ai = 0; ai < 2; ++ai)
#pragma unroll
            for (int m = 0; m < 4; ++m) rstd[ai][m] = rstd_of(rs + u.pm * BM + ai * HALF + wr * 64 + 4 * fr + m);
        const float* swp = sw + (size_t)(u.pm >> 5) * 2 * FFn + u.pn * BM + wc * 32 + 8 * fq;
#pragma unroll
        for (int n = 0; n < 2; ++n) { const int f = f0 + 4 * n; const f32x4 sa = *(const f32x4*)(swp + 4 * n), sb = *(const f32x4*)(swp + HALF + 4 * n);
            const f32x4 w0 = *(const f32x4*)(cw + f), w1 = *(const f32x4*)(cw + FFn + f), w2 = *(const f32x4*)(cw + 2 * FFn + f), wb = *(const f32x4*)(cb + f);
#pragma unroll
            for (int ai = 0; ai < 2; ++ai) { const int rowbase = u.pm * BM + ai * HALF + wr * 64, sp = rowbase >> 6;
                const f32x4 a0 = acc[ai][0][0][n] * rstd[ai][0] + sa, a1 = acc[ai][0][1][n] * rstd[ai][1] + sa, a2 = acc[ai][0][2][n] * rstd[ai][2] + sa, a3 = acc[ai][0][3][n] * rstd[ai][3] + sa;
                const f32x4 b0 = acc[ai][1][0][n] * rstd[ai][0] + sb, b1 = acc[ai][1][1][n] * rstd[ai][1] + sb, b2 = acc[ai][1][2][n] * rstd[ai][2] + sb, b3 = acc[ai][1][3][n] * rstd[ai][3] + sb;
                const f32x4 d3 = dpp_ror1(a3), d2 = dpp_ror1(a2);
                const f32x4 g0 = silu4_mul(wb + w0 * d2 + w1 * d3 + w2 * a0, b0);
                const f32x4 g1 = silu4_mul(wb + w0 * d3 + w1 * a0 + w2 * a1, b1);
                const f32x4 g2 = silu4_mul(wb + w0 * a0 + w1 * a1 + w2 * a2, b2);
                const f32x4 g3 = silu4_mul(wb + w0 * a1 + w1 * a2 + w2 * a3, b3);
                bf16_t* gp = G + (size_t)(rowbase + 4 * fr) * FFn + f;
                if (fr != 0) { u32x2 w; w.x = cvt_pk_bf16(g0[0], g0[1]); w.y = cvt_pk_bf16(g0[2], g0[3]); *(u32x2*)gp = w;
                               w.x = cvt_pk_bf16(g1[0], g1[1]); w.y = cvt_pk_bf16(g1[2], g1[3]); *(u32x2*)(gp + FFn) = w; }
                else { float* fa = fixa + (size_t)(sp * 2) * FFn + f; float* fb = fixb + (size_t)(sp * 2) * FFn + f;
                       *(f32x4*)fa = a0; *(f32x4*)(fa + FFn) = a1; *(f32x4*)fb = b0; *(f32x4*)(fb + FFn) = b1; }
                { u32x2 w; w.x = cvt_pk_bf16(g2[0], g2[1]); w.y = cvt_pk_bf16(g2[2], g2[3]); *(u32x2*)(gp + 2 * FFn) = w;
                  w.x = cvt_pk_bf16(g3[0], g3[1]); w.y = cvt_pk_bf16(g3[2], g3[3]); *(u32x2*)(gp + 3 * FFn) = w; }
                if (fr == 15) { float* hp = halo + (size_t)(sp * 2) * FFn + f; *(f32x4*)hp = a2; *(f32x4*)(hp + FFn) = a3; }
            } }
    }
};
template <bool BB  > struct EpiResNorm {
    static constexpr bool PERM = true, AFTER_DRAIN = false, APERM = false;
    const void* base; bf16_t* out; int ldc; const float* gate; int gstride; const float* gn; const float* scl; bf16_t* HB; float* rss;
    __device__ __forceinline__ void operator()(const f32x4 (&acc)[2][2][4][2], const Unit& u, int wr, int wc, int fr, int fq) const {
        const int col0 = u.pn * BM + wc * 32 + 8 * fq; const float* gp = gate + (size_t)(u.pm >> 5) * gstride + col0; const float* sp = scl + (size_t)(u.pm >> 5) * gstride + col0;
        f32x4 gv[2][2], gs[2][2];
#pragma unroll
        for (int bj = 0; bj < 2; ++bj)
#pragma unroll
            for (int n = 0; n < 2; ++n) { gv[bj][n] = *(const f32x4*)(gp + bj * HALF + n * 4); gs[bj][n] = *(const f32x4*)(gn + col0 + bj * HALF + n * 4) * (*(const f32x4*)(sp + bj * HALF + n * 4) + 1.0f); }
#pragma unroll
        for (int ai = 0; ai < 2; ++ai)
#pragma unroll
            for (int m = 0; m < 4; ++m) { const int row = u.pm * BM + ai * HALF + wr * 64 + m * 16 + fr; const size_t off = (size_t)row * ldc + col0; float ss = 0.f;
#pragma unroll
                for (int bj = 0; bj < 2; ++bj) { f32x4 bs0, bs1;
                    if (BB) { const u32x4 q = *(const u32x4*)((const bf16_t*)base + off + bj * HALF); bs0 = (f32x4){bf_lo(q.x), bf_hi(q.x), bf_lo(q.y), bf_hi(q.y)}; bs1 = (f32x4){bf_lo(q.z), bf_hi(q.z), bf_lo(q.w), bf_hi(q.w)}; }
                    else { bs0 = *(const f32x4*)((const float*)base + off + bj * HALF); bs1 = *(const f32x4*)((const float*)base + off + bj * HALF + 4); }
                    const f32x4 o0 = bs0 + gv[bj][0] * acc[ai][bj][m][0], o1 = bs1 + gv[bj][1] * acc[ai][bj][m][1];
                    { u32x4 wo; wo.x = cvt_pk_bf16(o0[0], o0[1]); wo.y = cvt_pk_bf16(o0[2], o0[3]); wo.z = cvt_pk_bf16(o1[0], o1[1]); wo.w = cvt_pk_bf16(o1[2], o1[3]); __builtin_nontemporal_store(wo, (u32x4*)(out + off + bj * HALF)); }
                    ss += ((o0[0] * o0[0] + o0[1] * o0[1]) + (o0[2] * o0[2] + o0[3] * o0[3])) + ((o1[0] * o1[0] + o1[1] * o1[1]) + (o1[2] * o1[2] + o1[3] * o1[3]));
                    const f32x4 h0 = o0 * gs[bj][0], h1 = o1 * gs[bj][1]; u32x4 w; w.x = cvt_pk_bf16(h0[0], h0[1]); w.y = cvt_pk_bf16(h0[2], h0[3]); w.z = cvt_pk_bf16(h1[0], h1[1]); w.w = cvt_pk_bf16(h1[2], h1[3]);
                    *(u32x4*)(HB + off + bj * HALF) = w; }
                ss += __shfl_xor(ss, 16); ss += __shfl_xor(ss, 32);
                if (fq == 0) unsafeAtomicAdd(rss + row, ss);
                if (m & 1) asm volatile("" ::: "memory"); }
    }
};
struct EpiRes {
    static constexpr bool PERM = false, AFTER_DRAIN = false, APERM = false;
    const float* base; float* out; int ldc; const float* gate; int gstride;
    __device__ __forceinline__ void operator()(const f32x4 (&acc)[2][2][4][2], const Unit& u, int wr, int wc, int fr, int fq) const {
        const int col0 = u.pn * BM + wc * 32 + 4 * fq; const float* gp = gate + (size_t)(u.pm >> 5) * gstride + col0;
        f32x4 gv[2][2];
#pragma unroll
        for (int bj = 0; bj < 2; ++bj)
#pragma unroll
            for (int n = 0; n < 2; ++n) gv[bj][n] = *(const f32x4*)(gp + bj * HALF + n * 16);
#pragma unroll
        for (int ai = 0; ai < 2; ++ai)
#pragma unroll
            for (int m = 0; m < 4; ++m) { const size_t off = (size_t)(u.pm * BM + ai * HALF + wr * 64 + m * 16 + fr) * ldc + col0;
#pragma unroll
                for (int bj = 0; bj < 2; ++bj)
#pragma unroll
                    for (int n = 0; n < 2; ++n) { const f32x4 bs = *(const f32x4*)(base + off + bj * HALF + n * 16);
                        *(f32x4*)(out + off + bj * HALF + n * 16) = bs + gv[bj][n] * acc[ai][bj][m][n]; }
                if (m & 1) asm volatile("" ::: "memory"); }
    }
};
struct EpiResFinal {
    static constexpr bool PERM = true, AFTER_DRAIN = true, APERM = false;
    const bf16_t* base; float* out; int ldc; const float* gate; int gstride; const float* gfin; unsigned* xbuf; unsigned* cnt;
    __device__ __forceinline__ void fused(f32x4 (&acc)[2][2][4][2], const Unit& u, int wr, int wc, int fr, int fq, PG8_LAS unsigned char* lds, int wid, int lane) const {
        PG8_LAS float* P = (PG8_LAS float*)lds; PG8_LAS float* S = (PG8_LAS float*)(lds + 8192);
        const int col0 = u.pn * BM + wc * 32 + 8 * fq; const float* gp = gate + (size_t)(u.pm >> 5) * gstride + col0;
        f32x4 gv[2][2];
#pragma unroll
        for (int bj = 0; bj < 2; ++bj)
#pragma unroll
            for (int n = 0; n < 2; ++n) gv[bj][n] = *(const f32x4*)(gp + bj * HALF + n * 4);
#pragma unroll
        for (int ai = 0; ai < 2; ++ai)
#pragma unroll
            for (int m = 0; m < 4; ++m) { const int r = ai * HALF + wr * 64 + m * 16 + fr; const size_t off = (size_t)(u.pm * BM + r) * ldc + col0; float ss = 0.f;
#pragma unroll
                for (int bj = 0; bj < 2; ++bj) { const u32x4 q = *(const u32x4*)(base + off + bj * HALF);
                    const f32x4 o0 = (f32x4){bf_lo(q.x), bf_hi(q.x), bf_lo(q.y), bf_hi(q.y)} + gv[bj][0] * acc[ai][bj][m][0], o1 = (f32x4){bf_lo(q.z), bf_hi(q.z), bf_lo(q.w), bf_hi(q.w)} + gv[bj][1] * acc[ai][bj][m][1];
                    acc[ai][bj][m][0] = o0; acc[ai][bj][m][1] = o1;
                    ss += ((o0[0] * o0[0] + o0[1] * o0[1]) + (o0[2] * o0[2] + o0[3] * o0[3])) + ((o1[0] * o1[0] + o1[1] * o1[1]) + (o1[2] * o1[2] + o1[3] * o1[3])); }
                ss += __shfl_xor(ss, 16); ss += __shfl_xor(ss, 32);
                if (fq == 0) P[r * 4 + wc] = ss;
                if (m & 1) asm volatile("" ::: "memory"); }
        asm volatile("s_waitcnt lgkmcnt(0)" ::: "memory"); __builtin_amdgcn_s_barrier(); asm volatile("" ::: "memory");
        const int row = wid * 32 + (lane & 31);
        if (lane < 32) { const float tot = (P[row * 4 + 0] + P[row * 4 + 1]) + (P[row * 4 + 2] + P[row * 4 + 3]);
            __hip_atomic_store(xbuf + ((size_t)(u.pm * BM + row) * 4 + u.pn), __float_as_uint(tot), __ATOMIC_RELAXED, __HIP_MEMORY_SCOPE_AGENT); }
        asm volatile("s_waitcnt vmcnt(0)" ::: "memory");
        if (lane == 0) __hip_atomic_fetch_add(cnt + 64 * u.pm, 1u, __ATOMIC_RELAXED, __HIP_MEMORY_SCOPE_AGENT);
        if (wid == 0) { for (unsigned sp = 0; sp < (1u << 24); ++sp) { if ((unsigned)__builtin_amdgcn_readfirstlane(__hip_atomic_load(cnt + 64 * u.pm, __ATOMIC_RELAXED, __HIP_MEMORY_SCOPE_AGENT)) >= 32u) break; __builtin_amdgcn_s_sleep(2); }
            __builtin_amdgcn_fence(__ATOMIC_ACQUIRE, "agent"); }
        asm volatile("s_waitcnt vmcnt(0) lgkmcnt(0)" ::: "memory"); __builtin_amdgcn_s_barrier(); asm volatile("" ::: "memory");
        if (lane < 32) { const unsigned* sl = xbuf + (size_t)(u.pm * BM + row) * 4; float q = 0.f;
#pragma unroll
            for (int t = 0; t < 4; ++t) q += __uint_as_float(__hip_atomic_load(sl + t, __ATOMIC_RELAXED, __HIP_MEMORY_SCOPE_AGENT));
            S[row] = 1.0f / sqrtf(q * (1.0f / 1024.0f) + 1e-6f); }
        asm volatile("s_waitcnt lgkmcnt(0)" ::: "memory"); __builtin_amdgcn_s_barrier(); asm volatile("" ::: "memory");
        f32x4 gf[2][2];
#pragma unroll
        for (int bj = 0; bj < 2; ++bj)
#pragma unroll
            for (int n = 0; n < 2; ++n) gf[bj][n] = *(const f32x4*)(gfin + col0 + bj * HALF + n * 4);
#pragma unroll
        for (int ai = 0; ai < 2; ++ai)
#pragma unroll
            for (int m = 0; m < 4; ++m) { const int r = ai * HALF + wr * 64 + m * 16 + fr; const size_t off = (size_t)(u.pm * BM + r) * ldc + col0; const float rstd = S[r];
#pragma unroll
                for (int bj = 0; bj < 2; ++bj)
#pragma unroll
                    for (int n = 0; n < 2; ++n) __builtin_nontemporal_store(acc[ai][bj][m][n] * rstd * gf[bj][n], (f32x4*)(out + off + bj * HALF + n * 4)); }
    }
};
template <class Epi, class Sched, bool ALIGN_EPI = false, bool SP2 = false>
__device__ __forceinline__ void gemm_phase(PG8_LAS unsigned char* lds, const Gemm g, const Sched& S, const Epi& E) {
    const int tid = opaque_tid(), wid = __builtin_amdgcn_readfirstlane(tid >> 6), lane = tid & 63, wr = wid >> 2, wc = wid & 3, fr = lane & 15, fq = lane >> 4;
    const int K = g.K, nt = K / BK, lda = g.lda;
    unsigned voffA[2], voffB[2];
#pragma unroll
    for (int i = 0; i < 2; ++i) { int R, C; stage_rc(tid * 16 + i * 8192, R, C); const int Rb = Epi::PERM ? ((R & ~31) + perm32(R & 31)) : R;
        const int Ra = Epi::APERM ? ((R & ~63) + 4 * (R & 15) + ((R >> 4) & 3)) : R;
        voffA[i] = (unsigned)(Ra * lda + C) * 2u; voffB[i] = (unsigned)(Rb * K + C) * 2u; }
    const size_t kstep = (size_t)(BK * 2);
    const size_t hstepA = (size_t)HALF * lda * 2, hstepB = (size_t)HALF * K * 2;
    const size_t tstepA = 2 * hstepA, tstepB = 2 * hstepB;
    const unsigned ldsw = (unsigned)wid * 1024u;
    const int aoff = lds_byte(wr * 64 + fr, fq * 8), boff = lds_byte(wc * 32 + fr, fq * 8);
#define PG8_SA(b, h) (((b) * 2 + (h)) * HTB)
#define PG8_SB(b, h) ((4 + (b) * 2 + (h)) * HTB)
#define PG8_STAGE(bufoff, gbase, voff) do { _Pragma("unroll") for (int _i = 0; _i < 2; ++_i) \
        __builtin_amdgcn_global_load_lds((const unsigned*)((const char*)(gbase) + (voff)[_i]), (PG8_LAS unsigned*)(lds + (bufoff) + ldsw + _i * 8192), 16, 0, 0); } while (0)
#define PG8_LDA(dst, b, h) do { _Pragma("unroll") for (int m = 0; m < 4; ++m) _Pragma("unroll") for (int k = 0; k < 2; ++k) dst[m][k] = *(const PG8_LAS bf16x8*)(lds + PG8_SA(b, h) + aoff + m * 2048 + k * 1024); } while (0)
#define PG8_LDB(dst, b, h) do { _Pragma("unroll") for (int n = 0; n < 2; ++n) _Pragma("unroll") for (int k = 0; k < 2; ++k) dst[n][k] = *(const PG8_LAS bf16x8*)(lds + PG8_SB(b, h) + boff + n * 2048 + k * 1024); } while (0)
#define PG8_MMA(ai, bj, At, Bt) do { __builtin_amdgcn_s_setprio(1); _Pragma("unroll") for (int m = 0; m < 4; ++m) _Pragma("unroll") for (int n = 0; n < 2; ++n) _Pragma("unroll") for (int k = 0; k < 2; ++k) \
        acc[ai][bj][m][n] = __builtin_amdgcn_mfma_f32_16x16x32_bf16(Bt[n][k], At[m][k], acc[ai][bj][m][n], 0, 0, 0); __builtin_amdgcn_s_setprio(0); } while (0)
#define PG8_WAIT_V(n) asm volatile("s_waitcnt vmcnt(" #n ")" ::: "memory")
#define PG8_WAIT_L(n) asm volatile("s_waitcnt lgkmcnt(" #n ")" ::: "memory")
#define PG8_BAR __builtin_amdgcn_s_barrier()
#define PG8_SCHED __builtin_amdgcn_sched_barrier(0)
    Unit cur, nxt; int ui = 0;
    if (!S.next(0, cur)) return;
    f32x4 acc[2][2][4][2];
#pragma unroll
    for (int a = 0; a < 2; ++a)
#pragma unroll
        for (int b = 0; b < 2; ++b)
#pragma unroll
            for (int m = 0; m < 4; ++m)
#pragma unroll
                for (int n = 0; n < 2; ++n) acc[a][b][m][n] = (f32x4){0.f, 0.f, 0.f, 0.f};
    bf16x8 At[4][2], B0[2][2], B1[2][2];
    const char* cA = (const char*)g.A + (size_t)cur.pm * tstepA; const char* cB = (const char*)g.Bt + (size_t)cur.pn * tstepB;
    S.a_ready(cur);
    if constexpr (SP2) {
        PG8_STAGE(PG8_SB(0, 0), cB, voffB); PG8_STAGE(PG8_SB(0, 1), cB + hstepB, voffB); PG8_STAGE(PG8_SA(0, 0), cA, voffA); PG8_STAGE(PG8_SA(0, 1), cA + hstepA, voffA);
        if (wr == 1) PG8_BAR;
        PG8_WAIT_V(2); PG8_BAR;
        PG8_STAGE(PG8_SB(1, 0), cB + kstep, voffB); PG8_STAGE(PG8_SA(1, 0), cA + kstep, voffA); PG8_STAGE(PG8_SB(1, 1), cB + hstepB + kstep, voffB);
        PG8_WAIT_V(6); PG8_BAR;
    } else {
        PG8_STAGE(PG8_SB(0, 0), cB, voffB); PG8_STAGE(PG8_SA(0, 0), cA, voffA); PG8_STAGE(PG8_SB(0, 1), cB + hstepB, voffB); PG8_STAGE(PG8_SA(0, 1), cA + hstepA, voffA);
        if (wr == 1) PG8_BAR;
        PG8_WAIT_V(4); PG8_BAR;
        PG8_STAGE(PG8_SB(1, 0), cB + kstep, voffB); PG8_STAGE(PG8_SA(1, 0), cA + kstep, voffA); PG8_STAGE(PG8_SB(1, 1), cB + hstepB + kstep, voffB);
        PG8_WAIT_V(6); PG8_BAR;
    }
    for (;;) {
        const bool has_next = S.next(ui + 1, nxt);
        const char* nA = has_next ? (const char*)g.A + (size_t)nxt.pm * tstepA : cA; const char* nB = has_next ? (const char*)g.Bt + (size_t)nxt.pn * tstepB : cB;
        for (int t = 0; t < nt; t += 2) {
            const bool last = (t == nt - 2);
            const char* a1 = cA + (size_t)(t + 1) * kstep;
            const char* a2 = last ? nA : cA + (size_t)(t + 2) * kstep; const char* b2 = last ? nB : cB + (size_t)(t + 2) * kstep;
            const char* a3 = a2 + kstep; const char* b3 = b2 + kstep;
            if (last && has_next) S.a_ready(nxt);
            if constexpr (SP2) {
            PG8_LDB(B0, 0, 0); PG8_LDB(B1, 0, 1); PG8_SCHED; PG8_LDA(At, 0, 0); PG8_STAGE(PG8_SA(1, 1), a1 + hstepA, voffA);
            PG8_WAIT_V(8); PG8_WAIT_L(0); PG8_BAR; PG8_MMA(0, 0, At, B0); PG8_MMA(0, 1, At, B1); PG8_BAR; PG8_SCHED;
            PG8_LDA(At, 0, 1); PG8_STAGE(PG8_SB(0, 0), b2, voffB); PG8_STAGE(PG8_SB(0, 1), b2 + hstepB, voffB); PG8_STAGE(PG8_SA(0, 0), a2, voffA);
            PG8_WAIT_V(8); PG8_WAIT_L(0); PG8_BAR; PG8_MMA(1, 0, At, B0); PG8_MMA(1, 1, At, B1); PG8_BAR; PG8_SCHED;
            PG8_LDB(B0, 1, 0); PG8_LDB(B1, 1, 1); PG8_SCHED; PG8_LDA(At, 1, 0); PG8_STAGE(PG8_SA(0, 1), a2 + hstepA, voffA);
            PG8_WAIT_V(8); PG8_WAIT_L(0); PG8_BAR; PG8_MMA(0, 0, At, B0); PG8_MMA(0, 1, At, B1); PG8_BAR; PG8_SCHED;
            PG8_LDA(At, 1, 1); PG8_STAGE(PG8_SB(1, 0), b3, voffB); PG8_STAGE(PG8_SB(1, 1), b3 + hstepB, voffB); PG8_STAGE(PG8_SA(1, 0), a3, voffA);
            PG8_WAIT_V(8); PG8_WAIT_L(0); PG8_BAR; PG8_MMA(1, 0, At, B0); PG8_MMA(1, 1, At, B1); PG8_BAR; PG8_SCHED;
            } else {
            PG8_LDB(B0, 0, 0); PG8_SCHED; PG8_LDA(At, 0, 0); PG8_STAGE(PG8_SA(1, 1), a1 + hstepA, voffA);
            PG8_WAIT_L(8); PG8_BAR; PG8_WAIT_L(0); PG8_MMA(0, 0, At, B0); PG8_BAR; PG8_SCHED;
            PG8_LDB(B1, 0, 1); PG8_STAGE(PG8_SB(0, 0), b2, voffB);
            PG8_BAR; PG8_WAIT_L(0); PG8_MMA(0, 1, At, B1); PG8_BAR;
            PG8_LDA(At, 0, 1); PG8_STAGE(PG8_SA(0, 0), a2, voffA);
            PG8_BAR; PG8_WAIT_L(0); PG8_MMA(1, 0, At, B0); PG8_BAR; PG8_SCHED;
            PG8_STAGE(PG8_SB(0, 1), b2 + hstepB, voffB);
            PG8_WAIT_V(6); PG8_BAR; PG8_MMA(1, 1, At, B1); PG8_BAR;
            PG8_LDB(B0, 1, 0); PG8_SCHED; PG8_LDA(At, 1, 0); PG8_STAGE(PG8_SA(0, 1), a2 + hstepA, voffA);
            PG8_WAIT_L(8); PG8_BAR; PG8_WAIT_L(0); PG8_MMA(0, 0, At, B0); PG8_BAR; PG8_SCHED;
            PG8_LDB(B1, 1, 1); PG8_STAGE(PG8_SB(1, 0), b3, voffB);
            PG8_BAR; PG8_WAIT_L(0); PG8_MMA(0, 1, At, B1); PG8_BAR;
            PG8_LDA(At, 1, 1); PG8_STAGE(PG8_SA(1, 0), a3, voffA);
            PG8_BAR; PG8_WAIT_L(0); PG8_MMA(1, 0, At, B0); PG8_BAR; PG8_SCHED;
            PG8_STAGE(PG8_SB(1, 1), b3 + hstepB, voffB);
            PG8_WAIT_V(6); PG8_BAR; PG8_MMA(1, 1, At, B1); PG8_BAR;
            }
        }
        if constexpr (ALIGN_EPI) { if (wr == 0) PG8_BAR; }
        if constexpr (!Epi::AFTER_DRAIN) { E(acc, cur, wr, wc, fr, fq); S.done(cur); }
        if (!has_next) break;
#pragma unroll
        for (int a = 0; a < 2; ++a)
#pragma unroll
            for (int b = 0; b < 2; ++b)
#pragma unroll
                for (int m = 0; m < 4; ++m)
#pragma unroll
                    for (int n = 0; n < 2; ++n) acc[a][b][m][n] = (f32x4){0.f, 0.f, 0.f, 0.f};
        cur = nxt; cA = nA; cB = nB; ++ui;
        if constexpr (ALIGN_EPI) { if (wr == 1) PG8_BAR; }
    }
    PG8_WAIT_V(0);
    if constexpr (!ALIGN_EPI) { if (wr == 0) PG8_BAR; }
    PG8_BAR;
    if constexpr (Epi::AFTER_DRAIN) { E.fused(acc, cur, wr, wc, fr, fq, lds, wid, lane); S.done(cur); }
#undef PG8_SA
#undef PG8_SB
#undef PG8_STAGE
#undef PG8_LDA
#undef PG8_LDB
#undef PG8_MMA
#undef PG8_WAIT_V
#undef PG8_WAIT_L
#undef PG8_BAR
#undef PG8_SCHED
}
}
#include <hip/hip_bf16.h>
#include <cmath>
namespace attn_body {
using bf16=__hip_bfloat16;
using bf16x8=__attribute__((ext_vector_type(8)))short;
using s16x4=__attribute__((ext_vector_type(4)))short;
using f32x16=__attribute__((ext_vector_type(16)))float;
using u32x4=__attribute__((ext_vector_type(4)))unsigned;
using f32x4v=__attribute__((ext_vector_type(4)))float;
constexpr int BATCH=2,NHEAD=16,SEQ=8192,D=64,DM=NHEAD*D;
constexpr int NW=8,QBLK=32,QB=QBLK*NW,KVBLK=64,NQB=SEQ/QB;
constexpr int ATTN_PITCH=DM, ATTN_UNIT_ROWS=QB;
__device__ __forceinline__ int crow(int r,int hi){return (r&3)+8*(r>>2)+4*hi;}
#define SBAR() __builtin_amdgcn_sched_barrier(0)
__device__ __forceinline__ void cmask(f32x16&p0,f32x16&p1,int jb,int qrel,int hi){
  const float NEG=-INFINITY; int kb=64*jb+4*hi;
  #pragma unroll
  for(int r=0;r<16;++r){int kv=kb+(r&3)+8*(r>>2); if(kv>qrel)p0[r]=NEG; if(kv+32>qrel)p1[r]=NEG;}
}

constexpr int NSLOT=3, SLOTB=8192;
constexpr int LDS_K=0, LDS_V=NSLOT*SLOTB, LDS_WS=2*NSLOT*SLOTB, LDS_OST=LDS_WS+NW*64*4, LDS_FB=LDS_OST+NW*4096, LDS_BYTES=LDS_FB+SEQ*4;
constexpr float C2=0.125f*1.4426950408889634f;
__device__ __forceinline__ void glds16(const void*gsrc,unsigned lds_dst){unsigned keep;
  asm volatile("s_mov_b32 %0, m0\n\ts_mov_b32 m0, %2\n\ts_nop 0\n\tglobal_load_lds_dwordx4 %1, off\n\ts_mov_b32 m0, %0":"=&s"(keep):"v"(gsrc),"s"(lds_dst):"memory");}
__device__ __forceinline__ float max3f(float a,float b,float c){float r;asm("v_max3_f32 %0, %1, %2, %3":"=v"(r):"v"(a),"v"(b),"v"(c));return r;}
__device__ __forceinline__ float max2f(float a,float b){float r;asm("v_max_f32_e32 %0, %1, %2":"=v"(r):"v"(a),"v"(b));return r;}
__device__ __forceinline__ float fadd_s(float a,float b){float r;asm("v_add_f32_e32 %0, %1, %2":"=v"(r):"v"(a),"v"(b));return r;}
__device__ __forceinline__ float fsub_s(float a,float b){float r;asm("v_sub_f32_e32 %0, %1, %2":"=v"(r):"v"(a),"v"(b));return r;}
typedef float f32x2_t __attribute__((ext_vector_type(2))); typedef __bf16 bf16x2_t __attribute__((ext_vector_type(2)));
__device__ __forceinline__ unsigned cvtpk_s(float lo,float hi){f32x2_t v={lo,hi};bf16x2_t b=__builtin_convertvector(v,bf16x2_t);return __builtin_bit_cast(unsigned,b);}
#define WAIT_BAR(N) asm volatile("s_waitcnt vmcnt(" #N ") lgkmcnt(0)\n\ts_barrier":::"memory")

__device__ __forceinline__ void qkt(f32x16&p0,f32x16&p1,const char*Kslot,const bf16x8*qr,const f32x16&c0in,const f32x16&c1in,int r32,int hi){
  const char*kb=Kslot+hi*1024+r32*16;
  #pragma unroll
  for(int d0=0;d0<4;++d0){
    const bf16x8 b0=*reinterpret_cast<const bf16x8*>(kb+d0*2048);
    const bf16x8 b1=*reinterpret_cast<const bf16x8*>(kb+d0*2048+512);
    if(d0==0){p0=__builtin_amdgcn_mfma_f32_32x32x16_bf16(b0,qr[0],c0in,0,0,0);p1=__builtin_amdgcn_mfma_f32_32x32x16_bf16(b1,qr[0],c1in,0,0,0);}
    else{p0=__builtin_amdgcn_mfma_f32_32x32x16_bf16(b0,qr[d0],p0,0,0,0);p1=__builtin_amdgcn_mfma_f32_32x32x16_bf16(b1,qr[d0],p1,0,0,0);}}
}
typedef __attribute__((address_space(3))) const char* lds_cptr;
typedef short v4i16_t __attribute__((ext_vector_type(4)));
__device__ __forceinline__ void kload8(bf16x8*kf,lds_cptr kp){
  kf[0]=*(const __attribute__((address_space(3))) bf16x8*)(kp);      kf[1]=*(const __attribute__((address_space(3))) bf16x8*)(kp+512);
  kf[2]=*(const __attribute__((address_space(3))) bf16x8*)(kp+2048); kf[3]=*(const __attribute__((address_space(3))) bf16x8*)(kp+2560);
  kf[4]=*(const __attribute__((address_space(3))) bf16x8*)(kp+4096); kf[5]=*(const __attribute__((address_space(3))) bf16x8*)(kp+4608);
  kf[6]=*(const __attribute__((address_space(3))) bf16x8*)(kp+6144); kf[7]=*(const __attribute__((address_space(3))) bf16x8*)(kp+6656);
}
__device__ __forceinline__ void kload2(bf16x8*kf,lds_cptr kp,int j){ kf[2*j]=*(const __attribute__((address_space(3))) bf16x8*)(kp+j*2048); kf[2*j+1]=*(const __attribute__((address_space(3))) bf16x8*)(kp+j*2048+512); }
__device__ __forceinline__ s16x4 vtr(lds_cptr p){ return __builtin_bit_cast(s16x4,__builtin_amdgcn_ds_read_tr16_b64_v4i16((__attribute__((address_space(3))) v4i16_t*)p)); }
__device__ __forceinline__ float rowmax(const f32x16&p0,const f32x16&p1){
  float a=max3f(p0[0],p0[1],p1[0]),b=max3f(p0[2],p0[3],p1[1]);a=max3f(a,p1[2],p1[3]);
  #pragma unroll
  for(int r=4;r<16;r+=4){a=max3f(a,p0[r],p0[r+1]);b=max3f(b,p0[r+2],p0[r+3]);a=max3f(a,p1[r],p1[r+1]);b=max3f(b,p1[r+2],p1[r+3]);}
  const float m=max2f(a,b);
  auto rr=__builtin_amdgcn_permlane32_swap(__float_as_uint(m),__float_as_uint(m),false,false);
  return max2f(__uint_as_float(rr[0]),__uint_as_float(rr[1]));
}
__device__ __forceinline__ void pv(f32x16*o,int vb,bf16x8 pa0,bf16x8 pa1,bf16x8 pa2,bf16x8 pa3){
  #pragma unroll
  for(int d0=0;d0<2;++d0){s16x4 lo[4],hi[4];
    #pragma unroll
    for(int ks=0;ks<4;++ks){
      asm volatile("ds_read_b64_tr_b16 %0,%1 offset:%c2":"=&v"(lo[ks]):"v"(vb),"i"(d0*4096+ks*1024):"memory");
      asm volatile("ds_read_b64_tr_b16 %0,%1 offset:%c2":"=&v"(hi[ks]):"v"(vb),"i"(d0*4096+ks*1024+512):"memory");}
    asm volatile("s_waitcnt lgkmcnt(0)":::"memory");SBAR();
    #define PK(k) (bf16x8){lo[k][0],lo[k][1],lo[k][2],lo[k][3],hi[k][0],hi[k][1],hi[k][2],hi[k][3]}
    o[d0]=__builtin_amdgcn_mfma_f32_32x32x16_bf16(pa0,PK(0),o[d0],0,0,0);
    o[d0]=__builtin_amdgcn_mfma_f32_32x32x16_bf16(pa1,PK(1),o[d0],0,0,0);
    o[d0]=__builtin_amdgcn_mfma_f32_32x32x16_bf16(pa2,PK(2),o[d0],0,0,0);
    o[d0]=__builtin_amdgcn_mfma_f32_32x32x16_bf16(pa3,PK(3),o[d0],0,0,0);
    #undef PK
  }
}

#ifndef ATTN_STORE16
#define ATTN_STORE16(p,v) (*(u32x4*)(p)=(v))
#endif
template<int THRL> __device__ __forceinline__ void attn_unit(int b,int h,int qb,const bf16*Q,const bf16*__restrict__ K,const bf16*__restrict__ V,bf16*O,const float*__restrict__ NLF,char*shm,const bool do_bias){
  const int tid=opaque_tid(),lane=tid&63,r32=lane&31,hi=lane>>5; const int wid=__builtin_amdgcn_readfirstlane(tid>>6);
  const long rowbase=(long)b*SEQ; const int q0=qb*QB;
  const bf16*Qw=Q+(rowbase+q0+wid*QBLK)*DM+h*D;
  const bf16*Kh=K+rowbase*DM+h*D,*Vh=V+rowbase*DM+h*D;
  const unsigned lds0=(unsigned)(uintptr_t)shm;
  float*wsf=(float*)(shm+LDS_WS)+wid*64;
  const bf16*ksrc=Kh+(long)lane*DM+wid*8;
  const bf16*vsrc=Vh+(long)(16*(wid&3)+(lane>>2))*DM+(wid>>2)*32+(lane&3)*8;
  const unsigned kdst=lds0+LDS_K+wid*1024, vdst=lds0+LDS_V+wid*1024;
  #define DMA_K(t,slot) glds16(ksrc+(long)(t)*KVBLK*DM,(unsigned)__builtin_amdgcn_readfirstlane(kdst+(slot)))
  #define DMA_V(t,slot) glds16(vsrc+(long)(t)*KVBLK*DM,(unsigned)__builtin_amdgcn_readfirstlane(vdst+(slot)))
  const int vb0=(int)(lds0+LDS_V)+((lane>>4)&1)*32+(lane&3)*8+(4*hi+((lane&15)>>2))*64;
  const char*Kbase=shm+LDS_K; bf16x8 kf[8];
  const lds_cptr shm3=(lds_cptr)shm; const lds_cptr kp0=shm3+LDS_K+hi*1024+r32*16; const lds_cptr vp0=shm3+LDS_V+((lane>>4)&1)*32+(lane&3)*8+(4*hi+((lane&15)>>2))*64;
  const int NT=(q0+QB)/KVBLK;
  typedef __attribute__((address_space(3))) f32x4v* lds_f4p;
  if(do_bias){ const int nkeys=SEQ; const int e0=tid*16; const bool act=e0<nkeys;
    f32x4v v0={0.f,0.f,0.f,0.f},v1=v0,v2=v0,v3=v0;
    if(act){ const f32x4v*src=reinterpret_cast<const f32x4v*>(NLF+(size_t)(b*NHEAD+h)*SEQ+e0); v0=src[0];v1=src[1];v2=src[2];v3=src[3]; }
    v0[1]+=v0[0];v0[2]+=v0[1];v0[3]+=v0[2]; v1[0]+=v0[3];v1[1]+=v1[0];v1[2]+=v1[1];v1[3]+=v1[2]; v2[0]+=v1[3];v2[1]+=v2[0];v2[2]+=v2[1];v2[3]+=v2[2]; v3[0]+=v2[3];v3[1]+=v3[0];v3[2]+=v3[1];v3[3]+=v3[2];
    const float tot=v3[3]; float x=tot;
    #pragma unroll
    for(int o=1;o<64;o<<=1){ const float y=__shfl_up(x,o); if(lane>=o)x+=y; }
    if(lane==63)wsf[0]=x;
    asm volatile("s_waitcnt vmcnt(0) lgkmcnt(0)\n\ts_barrier":::"memory");
    float offs=x-tot;
    #pragma unroll
    for(int w=0;w<NW;++w){ const float wt=((const float*)(shm+LDS_WS))[w*64]; if(w<wid)offs+=wt; }
    if(act){ lds_f4p dst=(lds_f4p)(shm+LDS_FB)+tid*4; dst[0]=v0+offs;dst[1]=v1+offs;dst[2]=v2+offs;dst[3]=v3+offs; }
    asm volatile("s_waitcnt vmcnt(0) lgkmcnt(0)\n\ts_barrier":::"memory");
  }
  const lds_f4p fbq=(lds_f4p)(shm+LDS_FB)+hi;
  #define LDBIAS(C0,C1,t) do{ const lds_f4p fp_=fbq+16*(t); const f32x4v a0_=fp_[0],a1_=fp_[2],a2_=fp_[4],a3_=fp_[6],b0_=fp_[8],b1_=fp_[10],b2_=fp_[12],b3_=fp_[14]; \
    _Pragma("unroll") for(int r_=0;r_<4;++r_){ C0[r_]=a0_[r_]-mhat;C0[4+r_]=a1_[r_]-mhat;C0[8+r_]=a2_[r_]-mhat;C0[12+r_]=a3_[r_]-mhat; C1[r_]=b0_[r_]-mhat;C1[4+r_]=b1_[r_]-mhat;C1[8+r_]=b2_[r_]-mhat;C1[12+r_]=b3_[r_]-mhat; } }while(0)
  #define LDB_LOAD(C0,C1,t) do{ const lds_f4p fp_=fbq+16*(t); const f32x4v a0_=fp_[0],a1_=fp_[2],a2_=fp_[4],a3_=fp_[6],b0_=fp_[8],b1_=fp_[10],b2_=fp_[12],b3_=fp_[14]; \
    _Pragma("unroll") for(int r_=0;r_<4;++r_){ C0[r_]=a0_[r_];C0[4+r_]=a1_[r_];C0[8+r_]=a2_[r_];C0[12+r_]=a3_[r_]; C1[r_]=b0_[r_];C1[4+r_]=b1_[r_];C1[8+r_]=b2_[r_];C1[12+r_]=b3_[r_]; } }while(0)
  #define LDB_SUB(C0,C1) do{ _Pragma("unroll") for(int r_=0;r_<16;++r_){ C0[r_]-=mhat; C1[r_]-=mhat; } }while(0)
  DMA_K(0,0);DMA_V(0,0);DMA_K(1,SLOTB);
  bf16x8 qr[4];
  #pragma unroll
  for(int d0=0;d0<4;++d0)qr[d0]=*reinterpret_cast<const bf16x8*>(&Qw[(long)r32*DM+d0*16+hi*8]);
  float mhat=0.f,l_reg=0.f;f32x16 o[2];o[0]=f32x16{};o[1]=f32x16{};
  const int qrel=wid*QBLK+r32;
  #define CMASK(P0,P1,t) do{int jb_=(t)-(NT-4); if(jb_>=0)cmask(P0,P1,jb_,qrel,hi);}while(0)
  bool resc=false;
  #define START(P0,P1) do{ const float rm=rowmax(P0,P1); resc=false; \
    { const float dl=rm; mhat=fadd_s(mhat,dl); \
      _Pragma("unroll") for(int r=0;r<16;++r){P0[r]=fsub_s(P0[r],dl);P1[r]=fsub_s(P1[r],dl);} \
      } \
    _Pragma("unroll") for(int r=0;r<16;++r)P0[r]=__builtin_amdgcn_exp2f(P0[r]); }while(0)
  #define RESC() do{ if(resc){ asm volatile("s_waitcnt lgkmcnt(0)":::"memory"); \
      _Pragma("unroll") for(int d_=0;d_<2;++d_) _Pragma("unroll") for(int r=0;r<16;++r)o[d_][r]*=wsf[crow(r,hi)]; } }while(0)
  f32x16 pA0,pA1,pB0,pB1;
  int sl_prev=0,sl_cur=0,sl_next=SLOTB;
  #define ROT() do{sl_prev=sl_cur;sl_cur=sl_next;sl_next=(sl_next==(NSLOT-1)*SLOTB)?0:sl_next+SLOTB;}while(0)
  DMA_K(2,2*SLOTB);
  WAIT_BAR(3);
  { f32x16 cA0,cA1; LDBIAS(cA0,cA1,0); qkt(pA0,pA1,Kbase,qr,cA0,cA1,r32,hi); } asm volatile("s_nop 15\n\ts_nop 7":"+v"(pA0),"+v"(pA1));CMASK(pA0,pA1,0);
  START(pA0,pA1);
  _Pragma("unroll") for(int r=0;r<16;++r)pA1[r]=__builtin_amdgcn_exp2f(pA1[r]);
  WAIT_BAR(0);
  DMA_K(3,0);DMA_V(1,SLOTB);
  ROT();
  kload8(kf,kp0+sl_cur);
  LDB_LOAD(pB0,pB1,1);
  WAIT_BAR(2);
  s16x4 vlo[8],vhi[8]; u32x4 pw0,pw1,pw2,pw3;
  #define PKW(P,B) cvtpk_s(P[B],P[B+1])
  #define PAF(k) __builtin_bit_cast(bf16x8,pw##k)
  #define VFR(i) (bf16x8){vlo[i][0],vlo[i][1],vlo[i][2],vlo[i][3],vhi[i][0],vhi[i][1],vhi[i][2],vhi[i][3]}
  #define PIN(x) asm volatile("":"+v"(x))
  #define MX3(a,b,c) __builtin_fmaxf(__builtin_fmaxf((a),(b)),(c))
  #define GAPA(MF,A0,A1,A2,A3,W0,W1,PW,CX) do{ MF; sacc+=A0; sacc+=A1; sacc+=A2; sacc+=A3; PIN(sacc); W0; W1; PIN(PW); asm volatile(""::"v"(CX)); SBAR(); }while(0)
  #define EX(v) __builtin_amdgcn_exp2f(v)
  #define GAPB(MF,X,B) do{ MF; X[B]=EX(X[B]); X[B+1]=EX(X[B+1]); X[B+2]=EX(X[B+2]); X[B+3]=EX(X[B+3]); PIN(X); SBAR(); }while(0)
  #define VRD(i) do{ vlo[i]=vtr(vp_+(((i)>>2)*4096+((i)&3)*1024)); vhi[i]=vtr(vp_+(((i)>>2)*4096+((i)&3)*1024+512)); }while(0)
  #define KRD(G,j) do{ if(G){ kload2(kf,kp0+sl_next,j); SBAR(); } }while(0)
  #define STEP(C0,C1,P0,P1,t,GK,GV,GL) do{ SBAR(); \
    LDB_SUB(C0,C1); asm volatile("":"+v"(C0),"+v"(C1)); SBAR(); \
    const lds_cptr vp_=vp0+sl_prev; \
    VRD(0); SBAR(); float sacc=(P0[0]+P0[1]); \
    GAPA(C0=__builtin_amdgcn_mfma_f32_32x32x16_bf16(kf[0],qr[0],C0,0,0,0), P0[2],P0[3],P0[4],P0[5],     pw0[0]=PKW(P0,0), pw0[1]=PKW(P0,2), pw0,C0); \
    VRD(4); SBAR(); GAPA(C1=__builtin_amdgcn_mfma_f32_32x32x16_bf16(kf[1],qr[0],C1,0,0,0), P0[6],P0[7],P0[8],P0[9],     pw0[2]=PKW(P0,4), pw0[3]=PKW(P0,6), pw0,C1); \
    VRD(1); SBAR(); GAPA(C0=__builtin_amdgcn_mfma_f32_32x32x16_bf16(kf[2],qr[1],C0,0,0,0),   P0[10],P0[11],P0[12],P0[13], pw1[0]=PKW(P0,8), pw1[1]=PKW(P0,10), pw1,C0); \
    VRD(5); SBAR(); GAPA(C1=__builtin_amdgcn_mfma_f32_32x32x16_bf16(kf[3],qr[1],C1,0,0,0),   P0[14],P0[15],P1[0],P1[1],   pw1[2]=PKW(P0,12),pw1[3]=PKW(P0,14), pw1,C1); \
    VRD(2); SBAR(); GAPA(C0=__builtin_amdgcn_mfma_f32_32x32x16_bf16(kf[4],qr[2],C0,0,0,0),   P1[2],P1[3],P1[4],P1[5],     pw2[0]=PKW(P1,0), pw2[1]=PKW(P1,2), pw2,C0); \
    VRD(6); SBAR(); GAPA(C1=__builtin_amdgcn_mfma_f32_32x32x16_bf16(kf[5],qr[2],C1,0,0,0),   P1[6],P1[7],P1[8],P1[9],     pw2[2]=PKW(P1,4), pw2[3]=PKW(P1,6), pw2,C1); \
    VRD(3); SBAR(); GAPA(C0=__builtin_amdgcn_mfma_f32_32x32x16_bf16(kf[6],qr[3],C0,0,0,0),   P1[10],P1[11],P1[12],P1[13], pw3[0]=PKW(P1,8), pw3[1]=PKW(P1,10), pw3,C0); \
    VRD(7); SBAR(); GAPA(C1=__builtin_amdgcn_mfma_f32_32x32x16_bf16(kf[7],qr[3],C1,0,0,0),   P1[14],P1[15],0.f,0.f,       pw3[2]=PKW(P1,12),pw3[3]=PKW(P1,14), pw3,C1); \
    l_reg+=sacc; \
    LDB_LOAD(P0,P1,(t)+1); \
    if(GK){DMA_K((t)+3,sl_cur);} if(GV){DMA_V((t)+1,sl_next);} \
    CMASK(C0,C1,t); \
    SBAR(); \
    o[0]=__builtin_amdgcn_mfma_f32_32x32x16_bf16(PAF(0),VFR(0),o[0],0,0,0); o[1]=__builtin_amdgcn_mfma_f32_32x32x16_bf16(PAF(0),VFR(4),o[1],0,0,0); \
    asm volatile(""::"v"(o[0]),"v"(o[1])); SBAR();     \
    { float a=MX3(C0[0],C0[1],C1[0]),b=MX3(C0[2],C0[3],C1[1]); a=MX3(a,C1[2],C1[3]); \
      _Pragma("unroll") for(int r=4;r<16;r+=4){a=MX3(a,C0[r],C0[r+1]);b=MX3(b,C0[r+2],C0[r+3]);a=MX3(a,C1[r],C1[r+1]);b=MX3(b,C1[r+2],C1[r+3]);} \
      float rm=__builtin_fmaxf(a,b); { auto rr=__builtin_amdgcn_permlane32_swap(__float_as_uint(rm),__float_as_uint(rm),false,false); rm=__builtin_fmaxf(__uint_as_float(rr[0]),__uint_as_float(rr[1])); } \
      resc=false; \
      if(__builtin_expect(__any(rm>(float)THRL),0)){ const float dl=__builtin_fmaxf(rm,0.f); mhat+=dl; \
        _Pragma("unroll") for(int r=0;r<16;++r){C0[r]-=dl;C1[r]-=dl;} \
        const float f=__builtin_amdgcn_exp2f(-dl); l_reg*=f; if(hi==0)wsf[r32]=f; resc=true; } } \
    SBAR(); \
    KRD(GL,0); o[0]=__builtin_amdgcn_mfma_f32_32x32x16_bf16(PAF(1),VFR(1),o[0],0,0,0); C0[0]=EX(C0[0]);C0[1]=EX(C0[1]);C0[2]=EX(C0[2]);C0[3]=EX(C0[3]);C0[4]=EX(C0[4]);C0[5]=EX(C0[5]); PIN(C0); SBAR(); \
    KRD(GL,1); o[1]=__builtin_amdgcn_mfma_f32_32x32x16_bf16(PAF(1),VFR(5),o[1],0,0,0); C0[6]=EX(C0[6]);C0[7]=EX(C0[7]);C0[8]=EX(C0[8]);C0[9]=EX(C0[9]);C0[10]=EX(C0[10]);C0[11]=EX(C0[11]); PIN(C0); SBAR(); \
    KRD(GL,2); o[0]=__builtin_amdgcn_mfma_f32_32x32x16_bf16(PAF(2),VFR(2),o[0],0,0,0); C0[12]=EX(C0[12]);C0[13]=EX(C0[13]);C0[14]=EX(C0[14]);C0[15]=EX(C0[15]);C1[0]=EX(C1[0]); PIN(C0); PIN(C1); SBAR(); \
    KRD(GL,3); o[1]=__builtin_amdgcn_mfma_f32_32x32x16_bf16(PAF(2),VFR(6),o[1],0,0,0); C1[1]=EX(C1[1]);C1[2]=EX(C1[2]);C1[3]=EX(C1[3]);C1[4]=EX(C1[4]);C1[5]=EX(C1[5]); PIN(C1); SBAR(); \
    o[0]=__builtin_amdgcn_mfma_f32_32x32x16_bf16(PAF(3),VFR(3),o[0],0,0,0); C1[6]=EX(C1[6]);C1[7]=EX(C1[7]);C1[8]=EX(C1[8]);C1[9]=EX(C1[9]);C1[10]=EX(C1[10]); PIN(C1); SBAR(); \
    o[1]=__builtin_amdgcn_mfma_f32_32x32x16_bf16(PAF(3),VFR(7),o[1],0,0,0); C1[11]=EX(C1[11]);C1[12]=EX(C1[12]);C1[13]=EX(C1[13]);C1[14]=EX(C1[14]);C1[15]=EX(C1[15]); PIN(C1); SBAR(); \
    }while(0)
  int t=1;
  #undef CMASK
  #define CMASK(P0,P1,t) do{}while(0)
  for(;t+5<NT;t+=2){
    STEP(pB0,pB1,pA0,pA1,t,true,true,true);     WAIT_BAR(2); RESC(); ROT();
    STEP(pA0,pA1,pB0,pB1,t+1,true,true,true);   WAIT_BAR(2); RESC(); ROT();
  }
  #undef CMASK
  #define CMASK(P0,P1,t) do{int jb_=(t)-(NT-4); if(jb_>=0)cmask(P0,P1,jb_,qrel,hi);}while(0)
  #define ENDW(tt) do{ if((tt)+3<NT){WAIT_BAR(2);} else if((tt)+2<NT){WAIT_BAR(1);} else {WAIT_BAR(0);} }while(0)
  for(;t+1<NT;t+=2){
    STEP(pB0,pB1,pA0,pA1,t,(t+3<NT),(t+1<NT),(t+1<NT));       ENDW(t);   RESC(); ROT();
    STEP(pA0,pA1,pB0,pB1,t+1,(t+4<NT),(t+2<NT),(t+2<NT));     ENDW(t+1); RESC(); ROT();
  }
  STEP(pB0,pB1,pA0,pA1,NT-1,false,false,false); RESC();
  { float sacc=pB0[0]+pB0[1]; _Pragma("unroll") for(int r=2;r<16;++r)sacc+=pB0[r]; _Pragma("unroll") for(int r=0;r<16;++r)sacc+=pB1[r]; l_reg+=sacc;
    pw0=(u32x4){PKW(pB0,0),PKW(pB0,2),PKW(pB0,4),PKW(pB0,6)};pw1=(u32x4){PKW(pB0,8),PKW(pB0,10),PKW(pB0,12),PKW(pB0,14)};pw2=(u32x4){PKW(pB1,0),PKW(pB1,2),PKW(pB1,4),PKW(pB1,6)};pw3=(u32x4){PKW(pB1,8),PKW(pB1,10),PKW(pB1,12),PKW(pB1,14)};
    SBAR(); pv(o,vb0+sl_cur,PAF(0),PAF(1),PAF(2),PAF(3)); }
  #undef PKW
  #undef PAF
  #undef VFR
  #undef PIN
  #undef MX3
  #undef GAPA
  #undef GAPB
  #undef EX
  #undef VRD
  #undef KRD
  #undef STEP
  #undef ENDW
  {auto rr=__builtin_amdgcn_permlane32_swap(__float_as_uint(l_reg),__float_as_uint(l_reg),false,false);l_reg=__uint_as_float(rr[0])+__uint_as_float(rr[1]);}
  if(hi==0)wsf[32+r32]=l_reg;asm volatile("s_waitcnt lgkmcnt(0)":::"memory");
  float rli[16];
  #pragma unroll
  for(int r=0;r<16;++r)rli[r]=__builtin_amdgcn_rcpf(wsf[32+crow(r,hi)]);
  bf16*Ow=O+(rowbase+q0+wid*QBLK)*DM+h*D;
  { bf16*stg=(bf16*)(shm+LDS_OST)+wid*2048;
    #pragma unroll
    for(int r=0;r<16;++r){const int orow=crow(r,hi);
      #pragma unroll
      for(int d0=0;d0<2;++d0)stg[orow*64+d0*32+r32]=__float2bfloat16(o[d0][r]*rli[r]);}
    asm volatile("s_waitcnt lgkmcnt(0)":::"memory");
    #pragma unroll
    for(int i=0;i<4;++i){const int row=i*8+(lane>>3),ch=lane&7; const u32x4 v=*(const u32x4*)(stg+row*64+ch*8); ATTN_STORE16(Ow+(long)row*DM+ch*8,v);} }
  asm volatile("s_waitcnt lgkmcnt(0)\n\ts_barrier":::"memory");
  #undef DMA_K
  #undef DMA_V
  #undef LDBIAS
  #undef LDB_LOAD
  #undef LDB_SUB
  #undef CMASK
  #undef START
  #undef RESC
  #undef ROT
}
constexpr int ATTN_LDS_BYTES=LDS_BYTES;
struct AttnTensors { const bf16* Q; const bf16* K; const bf16* V; bf16* O; const float* NLF; };
struct AttnUnit { int bh; int qb; };
struct StaticOrder {
  int vcu;
  __device__ __forceinline__ explicit StaticOrder(int grid,int block):vcu((block%8)*(grid/8)+block/8){}
  __device__ __forceinline__ bool next(int i,AttnUnit&u)const{ if(i>=4)return false; const int s=vcu&7; u.bh=vcu>>3; u.qb=(i==0)?s:(i==1)?15-s:(i==2)?16+s:31-s; return true; }
  __device__ __forceinline__ void a_ready(const AttnUnit&)const{}
  __device__ __forceinline__ void done(const AttnUnit&)const{}
};
template<class Sched,int THRL=8> __device__ __forceinline__ void attn_phase(char*lds,const AttnTensors&T,const Sched&S){
  AttnUnit u; int prev_bh=-1;
  for(int i=0;S.next(i,u);++i){ S.a_ready(u); attn_unit<THRL>(u.bh/NHEAD,u.bh%NHEAD,u.qb,T.Q,T.K,T.V,T.O,T.NLF,lds,(i==0)||(u.bh!=prev_bh)); prev_bh=u.bh; S.done(u); }
}
#undef SBAR
#undef WAIT_BAR
}
namespace cg = cooperative_groups;
#define GAS __attribute__((address_space(1)))
#define LAS __attribute__((address_space(3)))
typedef unsigned short bf16;
typedef unsigned v4u __attribute__((ext_vector_type(4)));
typedef unsigned v2u __attribute__((ext_vector_type(2)));
typedef float f32x4 __attribute__((ext_vector_type(4)));
typedef float f32x16 __attribute__((ext_vector_type(16)));
typedef short bf16x8 __attribute__((ext_vector_type(8)));
#define LDS_WAIT() asm volatile("s_waitcnt lgkmcnt(0)" ::: "memory")
__device__ __forceinline__ unsigned f2bf(float f) { unsigned u = __builtin_bit_cast(unsigned, f); return (u + 0x7fffu + ((u >> 16) & 1u)) >> 16; }
__device__ __forceinline__ unsigned pk2(float lo, float hi) { return f2bf(lo) | (f2bf(hi) << 16); }
__device__ __forceinline__ float bflo(unsigned w) { return __uint_as_float(w << 16); }
__device__ __forceinline__ float bfhi(unsigned w) { return __uint_as_float(w & 0xffff0000u); }

constexpr int NWAVES = 8;
constexpr int BATCH = 2, SEQ = 8192, D = 1024, M = BATCH * SEQ;
constexpr int FF = 2816, FF2 = 2 * FF;
constexpr int NQKV = 3328, NQKV_SRC = 3088;
constexpr int S5_LC = 256, S5_NCH = SEQ / S5_LC;
constexpr float RMS_EPS = 1e-6f;
constexpr int MODS = 3 * D;

constexpr size_t MiB = 1u << 20;
constexpr size_t WS_BAR = 0, WS_PCNT = 16384, BAR_BYTES = 32768;
constexpr size_t WS_XBUF = 512 * 1024;
constexpr size_t WS_MOD = 1 * MiB;
constexpr size_t WS_LAM = WS_MOD + 128 * 1024;
constexpr size_t WS_BF  = WS_LAM + 128 * 1024;
constexpr size_t WS_CF  = WS_BF + 256 * 1024;
constexpr size_t WS_RS = 2 * MiB;
constexpr size_t WS_SW = 2 * MiB + 256 * 1024;
constexpr size_t WS_W1 = 64 * MiB + 110 * MiB;
constexpr size_t WS_NLF = 3 * MiB;
constexpr size_t WS_SC  = 4 * MiB;
constexpr size_t WS_WUP = 6 * MiB, WS_WDN = 17 * MiB, WS_WC = 23 * MiB, WS_WA = 25 * MiB, WS_WB = 27 * MiB, WS_WQKV = 25 * MiB;
constexpr size_t WS_XN = 32 * MiB;
constexpr size_t WS_BIG = 64 * MiB;
constexpr size_t WS_END = 240 * MiB;
static_assert(WS_CF + 512 * 1024 <= WS_NLF && WS_WQKV + (size_t)NQKV * D * 2 <= WS_XN && WS_WDN + (size_t)D * FF * 2 <= WS_WC && WS_WUP + (size_t)FF2 * D * 2 <= WS_WDN, "ws map");
static_assert(WS_BIG + (size_t)M * FF2 * 2 <= WS_END, "ws map");

constexpr int RING_BYTES = 131072, LDS_BYTES = 147456;
static_assert(attn_body::ATTN_LDS_BYTES <= RING_BYTES, "attention LDS");

__device__ __forceinline__ float wave_sum(float v) {
#pragma unroll
    for (int o = 1; o < 64; o <<= 1) v += __shfl_xor(v, o);
    return v;
}
__device__ __forceinline__ void transpose_item(const float* W, int ldw, int nblk, int K, bf16* WT, int row_off, LAS float* scr, int item, int lane, int ilv = 0) {
    const int kb = item / nblk, nb = item % nblk, k0 = 64 * kb, n0 = 32 * nb;
    const int n0d = (ilv == 0) ? n0 : (n0 < ilv ? 256 * (n0 >> 7) + (n0 & 127) : 256 * ((n0 - ilv) >> 7) + 128 + ((n0 - ilv) & 127));
#pragma unroll 8
    for (int i = 0; i < 32; ++i) { const int kk = 2 * i + (lane >> 5); scr[kk * 33 + (lane & 31)] = W[(size_t)(k0 + kk) * ldw + n0 + (lane & 31)]; }
    LDS_WAIT(); asm volatile("" ::: "memory");
    const int c = lane & 7;
#pragma unroll
    for (int j = 0; j < 4; ++j) { const int n = (lane >> 3) + 8 * j; const LAS float* s = scr + (8 * c) * 33 + n;
        v4u o; o.x = pk2(s[0 * 33], s[1 * 33]); o.y = pk2(s[2 * 33], s[3 * 33]); o.z = pk2(s[4 * 33], s[5 * 33]); o.w = pk2(s[6 * 33], s[7 * 33]);
        *(GAS v4u*)(WT + (size_t)(row_off + n0d + n) * K + k0 + 8 * c) = o; }
    LDS_WAIT(); asm volatile("" ::: "memory");
}
__device__ __forceinline__ void norm_mod_phase(const float* X, bf16* XN, const float* g, const float* mod  , int gw, int NGW, int lane) {
    for (int b = 0; b < BATCH; ++b) {
        f32x4 gs[4], sh[4];
#pragma unroll
        for (int j = 0; j < 4; ++j) { const f32x4 gg = ((const f32x4*)g)[lane + 64 * j]; const f32x4 sc = ((const f32x4*)(mod + b * MODS + D))[lane + 64 * j];
            gs[j] = gg * (sc + 1.0f); sh[j] = ((const f32x4*)(mod + b * MODS))[lane + 64 * j]; }
        for (int t = gw; t < SEQ; t += NGW) { const size_t row = (size_t)b * SEQ + t;
            const f32x4* xr = (const f32x4*)(X + row * D) + lane; f32x4 v[4]; float s = 0.f;
#pragma unroll
            for (int j = 0; j < 4; ++j) { v[j] = xr[64 * j]; s += (v[j].x * v[j].x + v[j].y * v[j].y) + (v[j].z * v[j].z + v[j].w * v[j].w); }
            const float rstd = 1.0f / sqrtf(wave_sum(s) * (1.0f / D) + RMS_EPS);
            v2u* o8 = (v2u*)(XN + row * D) + lane;
#pragma unroll
            for (int j = 0; j < 4; ++j) { const f32x4 y = v[j] * rstd * gs[j] + sh[j]; v2u w; w.x = pk2(y.x, y.y); w.y = pk2(y.z, y.w); o8[64 * j] = w; }
        }
    }
}
__device__ __forceinline__ void final_norm_phase(float* X, const float* g, int gw, int NGW, int lane) {
    f32x4 gs[4];
#pragma unroll
    for (int j = 0; j < 4; ++j) gs[j] = ((const f32x4*)g)[lane + 64 * j];
    for (int row = gw; row < M; row += NGW) {
        f32x4* xr = (f32x4*)(X + (size_t)row * D) + lane; f32x4 v[4]; float s = 0.f;
#pragma unroll
        for (int j = 0; j < 4; ++j) { v[j] = xr[64 * j]; s += (v[j].x * v[j].x + v[j].y * v[j].y) + (v[j].z * v[j].z + v[j].w * v[j].w); }
        const float rstd = 1.0f / sqrtf(wave_sum(s) * (1.0f / D) + RMS_EPS);
#pragma unroll
        for (int j = 0; j < 4; ++j) xr[64 * j] = v[j] * rstd * gs[j];
    }
}
__device__ __forceinline__ void conv_phase(bf16* AB, const float* cw, const float* cb, int gw, int NGW, int lane) {
    constexpr int RB = 16, NRB = M / RB, NCB = 6, NCH = FF / 8;
    for (int it = gw; it < NRB * NCB; it += NGW) {
        const int cbk = it % NCB, rb = it / NCB, ch = cbk * 64 + lane; if (ch >= NCH) continue;
        const int f0 = ch * 8, r0 = rb * RB, t0 = r0 & (SEQ - 1);
        const f32x4 w0a = *(const f32x4*)(cw + f0), w0b = *(const f32x4*)(cw + f0 + 4), w1a = *(const f32x4*)(cw + FF + f0), w1b = *(const f32x4*)(cw + FF + f0 + 4),
                    w2a = *(const f32x4*)(cw + 2 * FF + f0), w2b = *(const f32x4*)(cw + 2 * FF + f0 + 4), cba = *(const f32x4*)(cb + f0), cbb = *(const f32x4*)(cb + f0 + 4);
        f32x4 p2a = {0.f, 0.f, 0.f, 0.f}, p2b = p2a, p1a = p2a, p1b = p2a;
        bf16* base = AB + (size_t)r0 * FF2 + f0;
        if (t0 != 0) { const v4u q2 = *(const v4u*)(base - 2 * (size_t)FF2), q1 = *(const v4u*)(base - (size_t)FF2);
            p2a = (f32x4){bflo(q2.x), bfhi(q2.x), bflo(q2.y), bfhi(q2.y)}; p2b = (f32x4){bflo(q2.z), bfhi(q2.z), bflo(q2.w), bfhi(q2.w)};
            p1a = (f32x4){bflo(q1.x), bfhi(q1.x), bflo(q1.y), bfhi(q1.y)}; p1b = (f32x4){bflo(q1.z), bfhi(q1.z), bflo(q1.w), bfhi(q1.w)}; }
#pragma unroll 4
        for (int i = 0; i < RB; ++i) { bf16* rp = base + (size_t)i * FF2;
            const v4u qa = *(const v4u*)rp, qb = *(const v4u*)(rp + FF);
            const f32x4 aa = {bflo(qa.x), bfhi(qa.x), bflo(qa.y), bfhi(qa.y)}, ab = {bflo(qa.z), bfhi(qa.z), bflo(qa.w), bfhi(qa.w)};
            const f32x4 ba = {bflo(qb.x), bfhi(qb.x), bflo(qb.y), bfhi(qb.y)}, bb = {bflo(qb.z), bfhi(qb.z), bflo(qb.w), bfhi(qb.w)};
            const f32x4 ca = cba + w0a * p2a + w1a * p1a + w2a * aa, cc = cbb + w0b * p2b + w1b * p1b + w2b * ab;
            f32x4 ga, gb;
#pragma unroll
            for (int e = 0; e < 4; ++e) { ga[e] = ca[e] * __builtin_amdgcn_rcpf(1.0f + __expf(-ca[e])) * ba[e]; gb[e] = cc[e] * __builtin_amdgcn_rcpf(1.0f + __expf(-cc[e])) * bb[e]; }
            v4u o; o.x = pk2(ga[0], ga[1]); o.y = pk2(ga[2], ga[3]); o.z = pk2(gb[0], gb[1]); o.w = pk2(gb[2], gb[3]);
            *(v4u*)(rp + FF) = o;
            p2a = p1a; p2b = p1b; p1a = aa; p1b = ab; }
    }
}
__device__ __forceinline__ void ffn_fixup(bf16* Gm, const float* fixa, const float* fixb, const float* halo, const float* cw, const float* cb, int pm, int tid) {
    constexpr int F4 = FF / 4;
    for (int it = tid; it < 8 * F4; it += NWAVES * 64) { const int f = (it % F4) * 4, rj = it / F4, sp = pm * 4 + (rj >> 1), j = rj & 1; const bool first = (sp & 127) == 0;
        const f32x4 z = {0.f, 0.f, 0.f, 0.f};
        const f32x4 a0 = *(const f32x4*)(fixa + (size_t)(sp * 2 + j) * FF + f), b0 = *(const f32x4*)(fixb + (size_t)(sp * 2 + j) * FF + f);
        const f32x4 h1 = first ? z : *(const f32x4*)(halo + (size_t)(sp * 2 - 1) * FF + f);
        const f32x4 h0 = first ? z : *(const f32x4*)(halo + (size_t)(sp * 2 - 2) * FF + f);
        const f32x4 am1 = (j == 0) ? h1 : *(const f32x4*)(fixa + (size_t)(sp * 2) * FF + f), am2 = (j == 0) ? h0 : h1;
        const f32x4 w0 = *(const f32x4*)(cw + f), w1 = *(const f32x4*)(cw + FF + f), w2 = *(const f32x4*)(cw + 2 * FF + f), wb = *(const f32x4*)(cb + f);
        const f32x4 c = wb + w0 * am2 + w1 * am1 + w2 * a0; f32x4 g;
#pragma unroll
        for (int e = 0; e < 4; ++e) g[e] = c[e] * __builtin_amdgcn_rcpf(1.0f + __expf(-c[e])) * b0[e];
        v2u w; w.x = pk2(g[0], g[1]); w.y = pk2(g[2], g[3]); *(v2u*)(Gm + (size_t)(sp * 64 + j) * FF + f) = w; }
}
__device__ __forceinline__ void s5_precompute(int g, int lane, const float* lam_re, const float* lam_im, const float* log_dt, const float* b_re, const float* b_im, const float* c_re, const float* c_im,
                                              float* LAM, bf16x8* BF, bf16x8* CF) {
    const int p0 = lane & 31, kh = lane >> 5; const float dt = expf(log_dt[g]);
    float lamv[8];
#pragma unroll
    for (int st = 0; st < 2; ++st) { const int p = p0 + 32 * st; const float lre = lam_re[g * 64 + p], lim = lam_im[g * 64 + p];
        const float mag = expf(lre * dt), ang = lim * dt; const float lbr = mag * cosf(ang), lbi = mag * sinf(ang);
        const float num_re = lbr - 1.0f, den = lre * lre + lim * lim; const float k_re = (num_re * lre + lbi * lim) / den, k_im = (lbi * lre - num_re * lim) / den;
        float Lr = lbr, Li = lbi;
#pragma unroll
        for (int s = 0; s < 8; ++s) { const float nr = Lr * Lr - Li * Li, ni = 2.0f * Lr * Li; Lr = nr; Li = ni; }
        lamv[2 * st] = lbr; lamv[2 * st + 1] = lbi; lamv[4 + 2 * st] = Lr; lamv[5 + 2 * st] = Li;
        const float* br = b_re + (size_t)(g * 64 + p) * 16 + 8 * kh; const float* bi = b_im + (size_t)(g * 64 + p) * 16 + 8 * kh;
        float re[8], im[8];
#pragma unroll
        for (int e = 0; e < 8; ++e) { re[e] = k_re * br[e] - k_im * bi[e]; im[e] = k_re * bi[e] + k_im * br[e]; }
        v4u wr, wi; wr.x = pk2(re[0], re[1]); wr.y = pk2(re[2], re[3]); wr.z = pk2(re[4], re[5]); wr.w = pk2(re[6], re[7]);
        wi.x = pk2(im[0], im[1]); wi.y = pk2(im[2], im[3]); wi.z = pk2(im[4], im[5]); wi.w = pk2(im[6], im[7]);
        ((v4u*)BF)[(g * 4 + st) * 64 + lane] = wr; ((v4u*)BF)[(g * 4 + 2 + st) * 64 + lane] = wi; }
    ((f32x4*)LAM)[(g * 64 + lane) * 2] = (f32x4){lamv[0], lamv[1], lamv[2], lamv[3]}; ((f32x4*)LAM)[(g * 64 + lane) * 2 + 1] = (f32x4){lamv[4], lamv[5], lamv[6], lamv[7]};
    const int c = lane & 31;
#pragma unroll
    for (int ks = 0; ks < 8; ++ks) { float v[8];
#pragma unroll
        for (int e = 0; e < 8; ++e) { const int kp = 16 * ks + 8 * kh + e, p = kp >> 2, j = kp & 3; float x = 0.f;
            if (c < 16) { const size_t idx = (size_t)(g * 16 + c) * 64 + p + ((j & 1) ? 32 : 0); x = (j < 2) ? c_re[idx] : -c_im[idx]; }
            v[e] = x; }
        v4u w; w.x = pk2(v[0], v[1]); w.y = pk2(v[2], v[3]); w.z = pk2(v[4], v[5]); w.w = pk2(v[6], v[7]);
        ((v4u*)CF)[(g * 8 + ks) * 64 + lane] = w; }
}
__device__ __forceinline__ float gelu_tanh(float v) { const float z = 1.5957691216057308f * (v + 0.044715f * v * v * v); return v * __builtin_amdgcn_rcpf(1.0f + __expf(-z)); }
template <bool OUT> __device__ __forceinline__ void s5_scan(LAS unsigned char* lds, const bf16* U, bf16* Y, float* SC, const float* LAM, const bf16x8* BF, const bf16x8* CF, const float* dskip, int bid, int G, int wave, int lane) {
    for (int unit = bid; unit < S5_NCH * 8; unit += G) {
        const int c = unit >> 3, g = (unit & 7) * 8 + wave;
        const int hb = lane >> 5, p0 = lane & 31;
        const f32x4 la = ((const f32x4*)LAM)[(g * 64 + lane) * 2];
        const float lr0 = la.x, li0 = la.y, lr1 = la.z, li1 = la.w;
        const bf16x8 bf0 = BF[(g * 4 + 0) * 64 + lane], bf1 = BF[(g * 4 + 1) * 64 + lane], bf2 = BF[(g * 4 + 2) * 64 + lane], bf3 = BF[(g * 4 + 3) * 64 + lane];
        float hr0 = 0.f, hi0 = 0.f, hr1 = 0.f, hi1 = 0.f;
        if (OUT) { const f32x4 Lb = ((const f32x4*)LAM)[(g * 64 + lane) * 2 + 1];
            for (int j0 = 0; j0 < c; j0 += 8) { f32x4 sv[8];
#pragma unroll
                for (int q = 0; q < 8; ++q) sv[q] = (j0 + q < c) ? ((const f32x4*)SC)[((size_t)(j0 + q) * 64 + g) * 64 + lane] : (f32x4){0.f, 0.f, 0.f, 0.f};
#pragma unroll
                for (int q = 0; q < 8; ++q) if (j0 + q < c) { const f32x4 s = sv[q];
                    const float nr0 = Lb.x * hr0 - Lb.y * hi0 + s.x, ni0 = Lb.x * hi0 + Lb.y * hr0 + s.y, nr1 = Lb.z * hr1 - Lb.w * hi1 + s.z, ni1 = Lb.z * hi1 + Lb.w * hr1 + s.w;
                    hr0 = nr0; hi0 = ni0; hr1 = nr1; hi1 = ni1; } } }
        const int m = lane & 31, bA = (m >> 2) & 1, jA = (m & 3) + 4 * (m >> 3), kh = lane >> 5;
        const bf16* up = U + ((size_t)bA * SEQ + (size_t)c * S5_LC + jA) * D + g * 16 + kh * 8;
        LAS unsigned char* hbuf = lds + wave * 8704;
        bf16x8 cf[8], dfrag = {0, 0, 0, 0, 0, 0, 0, 0};
        if (OUT) {
#pragma unroll
            for (int ks = 0; ks < 8; ++ks) cf[ks] = CF[(g * 8 + ks) * 64 + lane];
            if (p0 < 16 && (p0 >> 3) == kh) { const short dv = (short)f2bf(dskip[g * 16 + p0]);
#pragma unroll
                for (int e = 0; e < 8; ++e) if ((p0 & 7) == e) dfrag[e] = dv; } }
        bf16x8 af_n = *(const bf16x8*)up;
        for (int st = 0; st < S5_LC / 16; ++st) {
            const bf16x8 af = af_n; if (st + 1 < S5_LC / 16) af_n = *(const bf16x8*)(up + (size_t)(st + 1) * 16 * D);
            const f32x16 z16 = {0.f, 0.f, 0.f, 0.f, 0.f, 0.f, 0.f, 0.f, 0.f, 0.f, 0.f, 0.f, 0.f, 0.f, 0.f, 0.f};
            f32x16 d0 = __builtin_amdgcn_mfma_f32_32x32x16_bf16(af, bf0, z16, 0, 0, 0), d1 = __builtin_amdgcn_mfma_f32_32x32x16_bf16(af, bf1, z16, 0, 0, 0),
                   d2 = __builtin_amdgcn_mfma_f32_32x32x16_bf16(af, bf2, z16, 0, 0, 0), d3 = __builtin_amdgcn_mfma_f32_32x32x16_bf16(af, bf3, z16, 0, 0, 0);
#pragma unroll
            for (int i = 0; i < 16; ++i) {
                const float nr0 = fmaf(lr0, hr0, fmaf(-li0, hi0, d0[i])), ni0 = fmaf(lr0, hi0, fmaf(li0, hr0, d2[i]));
                const float nr1 = fmaf(lr1, hr1, fmaf(-li1, hi1, d1[i])), ni1 = fmaf(lr1, hi1, fmaf(li1, hr1, d3[i]));
                hr0 = nr0; hi0 = ni0; hr1 = nr1; hi1 = ni1; d0[i] = nr0; d2[i] = ni0; d1[i] = nr1; d3[i] = ni1; }
            if (OUT) {
#pragma unroll
                for (int i = 0; i < 16; ++i) { const int row = (i & 3) + 8 * (i >> 2) + 4 * hb; v2u w; w.x = pg8::cvt_pk_bf16(d0[i], d1[i]); w.y = pg8::cvt_pk_bf16(d2[i], d3[i]);
                    *(LAS v2u*)(hbuf + row * 272 + 8 * p0) = w; }
                f32x16 y = __builtin_amdgcn_mfma_f32_32x32x16_bf16(af, dfrag, z16, 0, 0, 0);
#pragma unroll
                for (int ks = 0; ks < 8; ++ks) { const bf16x8 a2 = *(const LAS bf16x8*)(hbuf + m * 272 + 32 * ks + 16 * kh); y = __builtin_amdgcn_mfma_f32_32x32x16_bf16(a2, cf[ks], y, 0, 0, 0); }
                if (p0 < 16) {
#pragma unroll
                    for (int i = 0; i < 16; ++i) *(LAS float*)(hbuf + ((i & 3) + 8 * (i >> 2) + 4 * hb) * 80 + 4 * p0) = y[i]; }
                { const int slot = lane >> 1, c8 = (lane & 1) * 8, sb = (slot >> 2) & 1, sj = (slot & 3) + 4 * (slot >> 3);
                  const f32x4 y0 = *(const LAS f32x4*)(hbuf + slot * 80 + 4 * c8), y1 = *(const LAS f32x4*)(hbuf + slot * 80 + 4 * c8 + 16);
                  v4u w; w.x = pg8::cvt_pk_bf16(gelu_tanh(y0[0]), gelu_tanh(y0[1])); w.y = pg8::cvt_pk_bf16(gelu_tanh(y0[2]), gelu_tanh(y0[3]));
                  w.z = pg8::cvt_pk_bf16(gelu_tanh(y1[0]), gelu_tanh(y1[1])); w.w = pg8::cvt_pk_bf16(gelu_tanh(y1[2]), gelu_tanh(y1[3]));
                  *(v4u*)(Y + ((size_t)sb * SEQ + (size_t)c * S5_LC + st * 16 + sj) * D + g * 16 + c8) = w; }
            }
        }
        if (!OUT) ((f32x4*)SC)[((size_t)c * 64 + g) * 64 + lane] = (f32x4){hr0, hi0, hr1, hi1};
    }
}
#define XB_TMO      128
#define XB_XCNT(j)  (256  + 64 * (j))
#define XB_XSUB(j)  (1280 + 64 * (j))
#define XB_XGEN(j)  (2304 + 64 * (j))
#define XB_TOP      3328
#define XB_TOPGEN   3392
#define XCD_BAR_WORDS 3456
#define XB_SPIN_CAP (1u << 18)

__device__ __forceinline__ unsigned xb_ld(unsigned* p)              { return __hip_atomic_load(p, __ATOMIC_RELAXED, __HIP_MEMORY_SCOPE_AGENT); }
__device__ __forceinline__ unsigned xb_add(unsigned* p, unsigned v) { return __hip_atomic_fetch_add(p, v, __ATOMIC_RELAXED, __HIP_MEMORY_SCOPE_AGENT); }
__device__ __forceinline__ unsigned xb_xcc_id() { return (unsigned)__builtin_amdgcn_s_getreg((3 << 11) | 20) & 0xFu; }
#define XB_SPIN(cond, bar) do { unsigned _sp = 0; while (cond) { __builtin_amdgcn_s_sleep(1); \
    if ((++_sp & 255u) == 0u) { if (xb_ld(&(bar)[XB_TMO])) break; if (_sp > XB_SPIN_CAP) { atomicAdd(&(bar)[XB_TMO], 1u); break; } } } } while (0)

struct XcdBarrier {
    unsigned* bar; unsigned x;
    volatile LAS unsigned* st;
};

__device__ __forceinline__ XcdBarrier xcd_barrier_post(unsigned* bar, volatile LAS unsigned* st) {
    XcdBarrier b; b.bar = bar; b.x = xb_xcc_id(); b.st = st;
    if (threadIdx.x == 0) (void)xb_add(&bar[XB_XCNT(b.x)], 1u);
    return b;
}
__device__ __forceinline__ void xcd_barrier_complete(unsigned* bar, unsigned x, unsigned& nloc, unsigned& nx) {
    const unsigned G = gridDim.x * gridDim.y * gridDim.z;
    unsigned sum, cnt, mine, sp = 0u;
    for (;;) {
        sum = 0u; cnt = 0u; mine = 0u;
#pragma unroll
        for (unsigned j = 0; j < 16; ++j) { const unsigned c = xb_ld(&bar[XB_XCNT(j)]); sum += c; cnt += (c > 0u) ? 1u : 0u; mine = (j == x) ? c : mine; }
        if (sum == G) break;
        __builtin_amdgcn_s_sleep(1);
        if ((++sp & 255u) == 0u) { if (xb_ld(&bar[XB_TMO])) break; if (sp > XB_SPIN_CAP) { atomicAdd(&bar[XB_TMO], 1u); break; } }
    }
    nloc = mine > 0u ? mine : 1u; nx = cnt > 0u ? cnt : 1u;
}

__device__ __forceinline__ void xcd_barrier(const XcdBarrier& b) {
    asm volatile("s_waitcnt vmcnt(0)" ::: "memory");
    __syncthreads();
    if (threadIdx.x == 0) {
        unsigned* bar = b.bar;
        __builtin_amdgcn_s_waitcnt(0);
        unsigned nloc = b.st[0], nx = b.st[1];
        if (nloc == 0u) { xcd_barrier_complete(bar, b.x, nloc, nx); b.st[0] = nloc; b.st[1] = nx; }
        const unsigned old = xb_add(&bar[XB_XSUB(b.x)], 1u);
        const unsigned gen = old / nloc;
        if (old + 1u == (gen + 1u) * nloc) {
            __builtin_amdgcn_fence(__ATOMIC_RELEASE, "agent");
            asm volatile("s_waitcnt vmcnt(0)" ::: "memory");
            const unsigned og = xb_add(&bar[XB_TOP], 1u);
            const unsigned tg = og / nx;
            if (og + 1u == (tg + 1u) * nx) xb_add(&bar[XB_TOPGEN], 1u);
            else XB_SPIN(xb_ld(&bar[XB_TOPGEN]) == tg, bar);
            __builtin_amdgcn_fence(__ATOMIC_ACQUIRE, "agent");
            xb_add(&bar[XB_XGEN(b.x)], 1u);
            asm volatile("s_waitcnt vmcnt(0)" ::: "memory");
        } else {
            XB_SPIN(xb_ld(&bar[XB_XGEN(b.x)]) == gen, bar);
            __builtin_amdgcn_fence(__ATOMIC_ACQUIRE, "agent");
            asm volatile("s_waitcnt vmcnt(0)" ::: "memory");
        }
    }
    __syncthreads();
}

constexpr int N_PHASES = 15;
#ifndef MK_PER_PHASE
#define MK_PER_PHASE 0
#endif
__device__ __forceinline__ void fgate_rows(const bf16* XNp, const bf16* Wf, const float* rs, const float* swf  , const float* bfg, float* nlf, int gw, int NGW, int lane) {
    const int r16 = lane & 15, kq = lane >> 4;
    for (int it = gw; it < M / 16; it += NGW) {
        const bf16* ap = XNp + (size_t)(it * 16 + r16) * D + kq * 8; const bf16* bp = Wf + (size_t)r16 * D + kq * 8;
        f32x4 acc = {0.f, 0.f, 0.f, 0.f};
#pragma unroll 8
        for (int ks = 0; ks < D / 32; ++ks) { const bf16x8 a = *(const bf16x8*)(ap + ks * 32), b = *(const bf16x8*)(bp + ks * 32); acc = __builtin_amdgcn_mfma_f32_16x16x32_bf16(a, b, acc, 0, 0, 0); }
        const int h = r16; const int bb = (it * 16) >> 13; const float add = swf[(size_t)bb * 3328 + h] + bfg[h];
#pragma unroll
        for (int i = 0; i < 4; ++i) { const int row = it * 16 + 4 * kq + i, t = row & 8191; const float x = acc[i] * pg8::rstd_of(rs + row) + add;
            const float e = __expf(-fabsf(x)); const float sp = fmaxf(-x, 0.0f) + ((e < 1e-3f) ? e * (1.0f - e * (0.5f - e * 0.33333333f)) : __logf(1.0f + e));
            nlf[(size_t)(bb * 16 + h) * 8192 + t] = sp * 1.4426950408889634f; }
    }
}
__device__ __forceinline__ void shiftw_rows(const bf16* WT, int N, const float* shift0, float* SW, int gw, int NGW, int lane) {
    f32x4 s0[4], s1[4];
#pragma unroll
    for (int j = 0; j < 4; ++j) { s0[j] = ((const f32x4*)shift0)[lane * 4 + j]; s1[j] = ((const f32x4*)(shift0 + MODS))[lane * 4 + j]; }
    for (int n = gw; n < N; n += NGW) { const v4u* wp = (const v4u*)(WT + (size_t)n * D) + lane * 2; const v4u q0 = wp[0], q1 = wp[1];
        const f32x4 w0 = {bflo(q0.x), bfhi(q0.x), bflo(q0.y), bfhi(q0.y)}, w1 = {bflo(q0.z), bfhi(q0.z), bflo(q0.w), bfhi(q0.w)}, w2 = {bflo(q1.x), bfhi(q1.x), bflo(q1.y), bfhi(q1.y)}, w3 = {bflo(q1.z), bfhi(q1.z), bflo(q1.w), bfhi(q1.w)};
        const f32x4 p0 = w0 * s0[0] + w1 * s0[1] + w2 * s0[2] + w3 * s0[3], p1 = w0 * s1[0] + w1 * s1[1] + w2 * s1[2] + w3 * s1[3];
        const float r0 = wave_sum((p0[0] + p0[1]) + (p0[2] + p0[3])), r1 = wave_sum((p1[0] + p1[1]) + (p1[2] + p1[3]));
        if (lane == 0) { SW[n] = r0; SW[N + n] = r1; } }
}
struct Args { const float* in[24]; float* out; unsigned char* ws; int ph_lo, ph_hi; };
#define ws (args.ws)
#define x_in (args.in[0])
#define cvec (args.in[1])
#define norm_g (args.in[2])
#define ada_w (args.in[3])
#define ada_b (args.in[4])
#define out (args.out)
#define MOD ((float*)(ws + WS_MOD))
#define MODS_(s) (MOD + (size_t)(s) * 2 * MODS)
#define LAM ((float*)(ws + WS_LAM))
#define BFm ((bf16x8*)(ws + WS_BF))
#define CFm ((bf16x8*)(ws + WS_CF))
#define NLF ((float*)(ws + WS_NLF))
#define SC ((float*)(ws + WS_SC))
#define RS_(k) ((float*)(ws + WS_RS) + (size_t)(k) * M)
#define SW_UP_(L) ((float*)(ws + WS_SW + ((L) == 0 ? 0 : 128 * 1024)))
#define SW_QKV ((float*)(ws + WS_SW + 64 * 1024))
#define W_A ((bf16*)(ws + WS_WA))
#define W_B ((bf16*)(ws + WS_WB))
#define W_C_(L) ((bf16*)(ws + ((L) == 0 ? WS_WC : WS_W1 + 7 * MiB)))
#define W_UP_(L) ((bf16*)(ws + ((L) == 0 ? WS_WUP : WS_W1 + 9 * MiB)))
#define W_DN_(L) ((bf16*)(ws + ((L) == 0 ? WS_WDN : WS_W1 + 20 * MiB)))
#define W_QKV ((bf16*)(ws + WS_W1))
#define XN ((bf16*)(ws + WS_XN))
#define BIG ((bf16*)(ws + WS_BIG))
#define FIXA ((float*)(ws + WS_BIG + 88 * MiB))
#define FIXB ((float*)(ws + WS_BIG + 94 * MiB))
#define HALO ((float*)(ws + WS_BIG + 100 * MiB))
#define HBF ((bf16*)(ws + WS_BIG + 136 * MiB))
#define T0 BIG
#define T1 (BIG + (size_t)M * D)
#define T2 (BIG + 2 * (size_t)M * D)
#define RUN(k) (lo <= (k) && (k) < hi)
#define SEAM(k) do { if (RUN(k) && RUN((k) + 1)) xcd_barrier(bar); } while (0)
#define IDS() const int tid = opaque_tid(), lane = tid & 63, wave = __builtin_amdgcn_readfirstlane(tid >> 6), gw = vcu * NWAVES + wave; (void)gw; (void)lane; LAS float* scr = (LAS float*)(lds + wave * 16384); (void)scr
#define hin ((L == 0) ? x_in : (const float*)out)
template <int L> __device__ __forceinline__ void layer_phases(const Args& args, const XcdBarrier& bar, LAS unsigned char* lds, unsigned char* lds_raw, const int G, const int bid, const int vcu, const int NGW, const int lo, const int hi) {
        const int pf = (L == 0) ? 7 : 12;
        if (L == 0) {
            if (RUN(2)) { pg8::Gemm g{XN, W_A, M, D, D, D}; pg8::StaticOrder S; S.init(M, D, G, bid); pg8::EpiBf16<0> E{T0, D, nullptr, 0, 0, 1.f};
                pg8::gemm_phase<pg8::EpiBf16<0>, pg8::StaticOrder, true, true>(lds, g, S, E); }
            SEAM(2);
            if (RUN(3)) { IDS(); s5_scan<false>(lds, T0, T1, SC, LAM, BFm, CFm, args.in[13], bid, G, wave, lane); }
            SEAM(3);
            if (RUN(4)) { IDS(); s5_scan<true>(lds, T0, T1, SC, LAM, BFm, CFm, args.in[13], bid, G, wave, lane); }
            SEAM(4);
            if (RUN(5)) { pg8::Gemm g{T1, W_B, M, D, D, D}; pg8::StaticOrder S; S.init(M, D, G, bid); pg8::EpiGlu E{T1, T2, D};
                pg8::gemm_phase<pg8::EpiGlu, pg8::StaticOrder, true, true>(lds, g, S, E); }
            SEAM(5);
            if (RUN(6)) { pg8::Gemm g{T2, W_C_(0), M, D, D, D}; pg8::StaticOrder S; S.init(M, D, G, bid);
                pg8::EpiResNorm<false> E{x_in, HBF, D, MODS_(0) + 2 * D, MODS, norm_g + (size_t)1 * D, MODS_(1) + D, XN, RS_(0)};
                pg8::gemm_phase<pg8::EpiResNorm<false>, pg8::StaticOrder, true, true>(lds, g, S, E); }
            SEAM(6);
        } else {
            if (RUN(9)) { pg8::Gemm g{XN, W_QKV, M, 3072, D, D}; pg8::StaticOrder S; S.init(M, 3072, G, bid);
                pg8::EpiQkvF E{T0, (size_t)M * D, attn_body::C2, args.in[17], NLF, RS_(1), SW_QKV};
                pg8::gemm_phase<pg8::EpiQkvF, pg8::StaticOrder, true, true>(lds, g, S, E);
                { IDS(); fgate_rows(XN, W_QKV + (size_t)3072 * D, RS_(1), SW_QKV + 3072, args.in[17], NLF, gw, NGW, lane); } }
            SEAM(9);
            if (RUN(10)) { const attn_body::AttnTensors AT{(const attn_body::bf16*)T0, (const attn_body::bf16*)T1, (const attn_body::bf16*)T2, (attn_body::bf16*)T0, NLF};
                const attn_body::StaticOrder S(G, bid); attn_body::attn_phase<attn_body::StaticOrder, 96>((char*)lds_raw, AT, S); }
            SEAM(10);
            if (RUN(11)) { pg8::Gemm g{T0, W_C_(1), M, D, D, D}; pg8::StaticOrder S; S.init(M, D, G, bid);
                pg8::EpiResNorm<true> E{HBF, HBF, D, MODS_(2) + 2 * D, MODS, norm_g + (size_t)3 * D, MODS_(3) + D, XN, RS_(2)};
                pg8::gemm_phase<pg8::EpiResNorm<true>, pg8::StaticOrder, true, true>(lds, g, S, E); }
            SEAM(11);
        }
        if (RUN(pf)) { pg8::Gemm g{XN, W_UP_(L), M, FF2, D, D}; pg8::StaticOrder S; S.init(M, FF2, G, bid);
            pg8::EpiConvGate E{BIG, FIXA, FIXB, HALO, args.in[20] + (size_t)L * 3 * FF, args.in[21] + (size_t)L * FF, FF, RS_(L == 0 ? 0 : 2), SW_UP_(L)};
            pg8::gemm_phase<pg8::EpiConvGate, pg8::StaticOrder, true, true>(lds, g, S, E);
            if (L == 0) {
                IDS(); const int rem = S.nwg % G; const bool idle = (rem == 0) || bid >= rem; const int nidle = (rem == 0) ? G : G - rem, gwl = ((rem == 0) ? bid : bid - rem) * NWAVES + wave, NGL = nidle * NWAVES;
                if (idle) {
                    constexpr int I_SQ = (D / 64) * (D / 32), I_UP = (D / 64) * (FF2 / 32), I_DN = (FF / 64) * (D / 32), I_QKV = (D / 64) * (3072 / 32);
                    constexpr int NITEMS = I_SQ + I_UP + 2 * I_DN + I_QKV;
                    for (int it = gwl; it < NITEMS; it += NGL) { int r = it;
                        if (r < I_DN) { transpose_item(args.in[22], D, D / 32, FF, W_DN_(0), 0, scr, r, lane); continue; } r -= I_DN;
                        if (r < I_QKV) { transpose_item(args.in[16], NQKV_SRC, 3072 / 32, D, W_QKV, 0, scr, r, lane); continue; } r -= I_QKV;
                        if (r < I_SQ) { transpose_item(args.in[18], D, D / 32, D, W_C_(1), 0, scr, r, lane); continue; } r -= I_SQ;
                        if (r < I_UP) { transpose_item(args.in[19] + (size_t)D * FF2, FF2, FF2 / 32, D, W_UP_(1), 0, scr, r, lane, FF); continue; } r -= I_UP;
                        transpose_item(args.in[22] + (size_t)FF * D, D, D / 32, FF, W_DN_(1), 0, scr, r, lane); }
                    const float* fox_w_in = args.in[16]; const int gt = gwl * 64 + lane, NGT = NGL * 64;
                    for (int i = gt; i < 16 * D; i += NGT) { const int n = i >> 10, k = i & 1023; W_QKV[(size_t)(3072 + n) * D + k] = (bf16)f2bf(fox_w_in[(size_t)k * NQKV_SRC + 3072 + n]); }
                    for (int i = gt; i < (NQKV - NQKV_SRC) * D / 8; i += NGT) ((v4u*)(W_QKV + (size_t)NQKV_SRC * D))[i] = (v4u){0u, 0u, 0u, 0u};
                } } }
        SEAM(pf);
        if (RUN(pf + 1)) { pg8::Gemm g{BIG, W_DN_(L), M, D, FF, FF}; pg8::StaticOrder S; S.init(M, D, G, bid);
            if (L == 0) { IDS(); shiftw_rows(W_QKV, NQKV, MODS_(2), SW_QKV, gw, NGW, lane); shiftw_rows(W_UP_(1), FF2, MODS_(3), SW_UP_(1), gw, NGW, lane); }
            { IDS(); pg8::Unit uu; for (int i = 0; S.next(i, uu); ++i) ffn_fixup(BIG, FIXA, FIXB, HALO, args.in[20] + (size_t)L * 3 * FF, args.in[21] + (size_t)L * FF, uu.pm, tid);
              asm volatile("s_waitcnt vmcnt(0)" ::: "memory"); __syncthreads(); }
            if (L == 0) { pg8::EpiResNorm<true> E{HBF, HBF, D, MODS_(1) + 2 * D, MODS, norm_g + (size_t)2 * D, MODS_(2) + D, XN, RS_(1)};
                pg8::gemm_phase<pg8::EpiResNorm<true>, pg8::StaticOrder, true, true>(lds, g, S, E); }
            else { pg8::EpiResFinal E{HBF, out, D, MODS_(3) + 2 * D, MODS, args.in[23], (unsigned*)(ws + WS_XBUF), (unsigned*)(ws + WS_PCNT)};
                pg8::gemm_phase<pg8::EpiResFinal, pg8::StaticOrder, false, true>(lds, g, S, E); }
            }
        if (L == 0) SEAM(pf + 1);
    }
__global__ void __launch_bounds__(NWAVES * 64, 2) mk_fwd(Args args) {
    extern __shared__ __attribute__((aligned(16))) unsigned char lds_raw[];
    cg::grid_group grid = cg::this_grid();
    LAS unsigned char* lds = (LAS unsigned char*)lds_raw;
    const int G = gridDim.x, bid = blockIdx.x;
    const int vcu = (G % 8 == 0) ? (bid % 8) * (G / 8) + bid / 8 : bid;
    const int NGW = G * NWAVES;
    const int lo = args.ph_lo, hi = args.ph_hi;
    if (lo < 0) grid.sync();
    volatile LAS unsigned* MISC = (volatile LAS unsigned*)(lds + RING_BYTES + 320);
    if (threadIdx.x < 32) MISC[threadIdx.x] = 0u;
    __syncthreads();
    const XcdBarrier bar = xcd_barrier_post((unsigned*)(ws + WS_BAR), MISC + 8);

    if (RUN(0)) { IDS();
        for (int it = bid; it < 4 * 48; it += G) {
            const int s = it / 48, cb = it % 48, n = 64 * cb + lane;
            const float* wp = ada_w + ((size_t)s * D + 128 * wave) * MODS + n; const float* c0 = cvec + 128 * wave; const float* c1 = cvec + D + 128 * wave;
            float a0 = 0.f, a1 = 0.f;
#pragma unroll 8
            for (int k = 0; k < 128; ++k) { const float wv = wp[(size_t)k * MODS]; const float x0 = c0[k], x1 = c1[k];
                a0 += x0 * __builtin_amdgcn_rcpf(1.0f + __expf(-x0)) * wv; a1 += x1 * __builtin_amdgcn_rcpf(1.0f + __expf(-x1)) * wv; }
            LAS float* red = (LAS float*)lds;
            red[(wave * 2 + 0) * 64 + lane] = a0; red[(wave * 2 + 1) * 64 + lane] = a1;
            __syncthreads();
            if (wave < 2) { float sm = 0.f;
#pragma unroll
                for (int w = 0; w < 8; ++w) sm += red[(w * 2 + wave) * 64 + lane];
                MOD[(size_t)(s * 2 + wave) * MODS + n] = sm + ada_b[s * MODS + n]; }
            __syncthreads();
        }
        {
            constexpr int I_SQ = (D / 64) * (D / 32), I_UP = (D / 64) * (FF2 / 32);
            constexpr int NITEMS = 3 * I_SQ + I_UP;
            for (int it = gw; it < NITEMS; it += NGW) { int r = it;
                if (r < I_SQ) { transpose_item(args.in[5], D, D / 32, D, W_A, 0, scr, r, lane); continue; } r -= I_SQ;
                if (r < I_SQ) { transpose_item(args.in[14], D, D / 32, D, W_B, 0, scr, r, lane); continue; } r -= I_SQ;
                if (r < I_SQ) { transpose_item(args.in[15], D, D / 32, D, W_C_(0), 0, scr, r, lane); continue; } r -= I_SQ;
                transpose_item(args.in[19], FF2, FF2 / 32, D, W_UP_(0), 0, scr, r, lane, FF); }
            const int gt = gw * 64 + lane, NGT = NGW * 64;
            for (int i = gt; i < 3 * M / 4; i += NGT) ((f32x4*)RS_(0))[i] = (f32x4){0.f, 0.f, 0.f, 0.f};
        }
        { const int g = gw - (NGW - 64); if (g >= 0 && g < 64) s5_precompute(g, lane, args.in[6], args.in[7], args.in[8], args.in[9], args.in[10], args.in[11], args.in[12], LAM, BFm, CFm); }
    }
    SEAM(0);
    if (RUN(1)) { IDS();
        norm_mod_phase(x_in, XN, norm_g, MODS_(0), gw, NGW, lane);
        shiftw_rows(W_UP_(0), FF2, MODS_(1), SW_UP_(0), gw, NGW, lane);
    }
    SEAM(1);

    layer_phases<0>(args, bar, lds, lds_raw, G, bid, vcu, NGW, lo, hi);
    layer_phases<1>(args, bar, lds, lds_raw, G, bid, vcu, NGW, lo, hi);
#undef RUN
#undef SEAM
#undef ws
#undef x_in
#undef cvec
#undef norm_g
#undef ada_w
#undef ada_b
#undef out
#undef hin
}

extern "C" void kernel_launch(void* const* d_in, const int* in_sizes, int n_in, void* d_out, int out_size, void* d_ws, size_t ws_size, hipStream_t stream) {
    static int grid = 0;
    if (grid == 0) {
        if (n_in != 24 || in_sizes[0] != M * D || out_size != M * D || ws_size < WS_END) { fprintf(stderr, "kernel_launch: unexpected shapes (n_in %d, in0 %d, out %d, ws %zu)\n", n_in, n_in > 0 ? in_sizes[0] : -1, out_size, ws_size); grid = -1; return; }
        int dev = 0, cus = 0, per_cu = 0;
        if (hipGetDevice(&dev) != hipSuccess || hipDeviceGetAttribute(&cus, hipDeviceAttributeMultiprocessorCount, dev) != hipSuccess) { grid = -1; return; }
        if (hipFuncSetAttribute((const void*)mk_fwd, hipFuncAttributeMaxDynamicSharedMemorySize, LDS_BYTES) != hipSuccess) { fprintf(stderr, "kernel_launch: hipFuncSetAttribute failed\n"); grid = -1; return; }
        if (hipOccupancyMaxActiveBlocksPerMultiprocessor(&per_cu, (const void*)mk_fwd, NWAVES * 64, LDS_BYTES) != hipSuccess || per_cu < 1) { fprintf(stderr, "kernel_launch: occupancy query says %d\n", per_cu); per_cu = 1; }
        (void)hipGetLastError();
        grid = cus * 1;
        if (grid != 256) { fprintf(stderr, "kernel_launch: %d CUs; this kernel is built for 256 (one workgroup per CU); nothing launched\n", grid); grid = -1; return; }
    }
    if (grid < 0) return;
    if (hipMemsetAsync((char*)d_ws + WS_BAR, 0, BAR_BYTES, stream) != hipSuccess) { fprintf(stderr, "kernel_launch: memset failed\n"); return; }
    Args a{};
    for (int i = 0; i < 24; ++i) a.in[i] = (const float*)d_in[i];
    a.out = (float*)d_out; a.ws = (unsigned char*)d_ws;
    void* kargs[] = {&a};
#if MK_PER_PHASE
    for (int k = 0; k < N_PHASES; ++k) { a.ph_lo = k; a.ph_hi = k + 1;
        hipError_t e = hipLaunchCooperativeKernel((const void*)mk_fwd, dim3(grid), dim3(NWAVES * 64), kargs, LDS_BYTES, stream);
        if (e != hipSuccess) { fprintf(stderr, "kernel_launch: launch %d failed: %s\n", k, hipGetErrorString(e)); break; } }
#else
    a.ph_lo = 0; a.ph_hi = N_PHASES;
    hipError_t e = hipLaunchCooperativeKernel((const void*)mk_fwd, dim3(grid), dim3(NWAVES * 64), kargs, LDS_BYTES, stream);
    if (e != hipSuccess) fprintf(stderr, "kernel_launch: cooperative launch failed: %s (grid %d)\n", hipGetErrorString(e), grid);
#endif
}
```

```cpp
#include <hip/hip_runtime.h>
#include <hip/hip_cooperative_groups.h>
#include <cstdio>
#include <cstdint>
__device__ __forceinline__ int opaque_tid() { int t; asm volatile("v_mov_b32 %0, %1" : "=v"(t) : "v"((int)threadIdx.x)); return t; }
namespace pg8 {
#define PG8_LAS __attribute__((address_space(3)))
typedef unsigned short bf16_t;
typedef short bf16x8 __attribute__((ext_vector_type(8)));
typedef float f32x4 __attribute__((ext_vector_type(4)));
typedef unsigned u32x4 __attribute__((ext_vector_type(4)));
constexpr int BM = 256, BK = 64, HALF = 128, HTB = HALF * BK * 2  , STAGE_BYTES = 8 * HTB, NXCD = 8, WGM = 8;

__host__ __device__ __forceinline__ int lds_byte(int r, int c) { const int st = (r >> 4) * 2 + (c >> 5), rr = r & 15, cc = c & 31, ob = rr * 64 + cc * 2; return st * 1024 + (ob ^ (((ob >> 9) & 1) << 5)); }
__host__ __device__ __forceinline__ void stage_rc(int b, int& R, int& C) { const int st = b / 1024, sb = b % 1024, swz = sb ^ (((sb >> 9) & 1) << 5); R = (st >> 1) * 16 + swz / 64; C = (st & 1) * 32 + (swz % 64) / 2; }
__host__ __device__ __forceinline__ int perm32(int rho) { const int n = rho >> 4, i = rho & 15; return 8 * (i >> 2) + 4 * n + (i & 3); }

struct Unit { int pm, pn; };
struct Gemm { const bf16_t* A; const bf16_t* Bt; int M, N, K, lda; };

struct StaticOrder {
    int nM, nN, nwg, G, c;
    __host__ __device__ void init(int M, int N, int G_, int c_) { nM = M / BM; nN = N / BM; nwg = nM * nN; G = G_; c = c_; }
    __host__ __device__ bool next(int i, Unit& u) const {
        const long L = (long)i * G + c; if (L >= nwg) return false;
        int wgid = (int)L; { const int q = nwg / NXCD, r = nwg % NXCD, xcd = wgid % NXCD, off = wgid / NXCD; wgid = (xcd < r ? xcd * (q + 1) : r * (q + 1) + (xcd - r) * q) + off; }
        const int nig = WGM * nN, gid = wgid / nig, fm = gid * WGM, gsz = (nM - fm) < WGM ? (nM - fm) : WGM;
        u.pm = fm + ((wgid % nig) % gsz); u.pn = (wgid % nig) / gsz; return true;
    }
    __device__ __forceinline__ void a_ready(const Unit&) const {}
    __device__ __forceinline__ void done(const Unit&) const {}
};

__device__ __forceinline__ unsigned cvt_pk_bf16(float lo, float hi) { unsigned r; asm volatile("v_cvt_pk_bf16_f32 %0, %1, %2" : "=v"(r) : "v"(lo), "v"(hi)); return r; }
typedef float f32x2 __attribute__((ext_vector_type(2)));
__device__ __forceinline__ f32x2 gelu_pk(f32x2 v) {
    const f32x2 av = __builtin_elementwise_abs(v), d = av * 0.2316418882f + 1.0f;
    f32x2 t; t.x = __builtin_amdgcn_rcpf(d.x); t.y = __builtin_amdgcn_rcpf(d.y);
    f32x2 q = t * 0.5307027145f + (-0.7265760135f); q = q * t + 0.7107068705f; q = q * t + (-0.142248368f); q = q * t + 0.127414796f; q = q * t;
    const f32x2 s = (v * v) * (-0.72134752044f);
    f32x2 e; e.x = __builtin_amdgcn_exp2f(s.x); e.y = __builtin_amdgcn_exp2f(s.y);
    const f32x2 m = v * (q * e), r = v - m;
    f32x2 o; o.x = v.x < 0.f ? m.x : r.x; o.y = v.y < 0.f ? m.y : r.y; return o;
}

template <int ACT  > struct EpiBf16 {
    static constexpr bool PERM = true, AFTER_DRAIN = false, APERM = false; static_assert(ACT == 0 || ACT == 1, "EpiBf16: ACT is 0 (none) or 1 (gelu_pk)");
    bf16_t* O; int ldc; const float* bias; int split_cols; size_t split_stride; float scale0;
    __device__ __forceinline__ void operator()(const f32x4 (&acc)[2][2][4][2], const Unit& u, int wr, int wc, int fr, int fq) const {
        const int row0 = u.pm * BM + wr * 64 + fr; int colt = u.pn * BM; bf16_t* base = O;
        float sc = 1.f; if (split_cols) { const int t = colt / split_cols; base += (size_t)t * split_stride; colt -= t * split_cols; if (t == 0) sc = scale0; }
        const int col0 = colt + wc * 32 + 8 * fq, bcol0 = u.pn * BM + wc * 32 + 8 * fq;
        f32x4 bv[2][2];
#pragma unroll
        for (int bj = 0; bj < 2; ++bj)
#pragma unroll
            for (int n = 0; n < 2; ++n) bv[bj][n] = bias ? *(const f32x4*)(bias + bcol0 + bj * HALF + 4 * n) : (f32x4){0.f, 0.f, 0.f, 0.f};
#pragma unroll
        for (int ai = 0; ai < 2; ++ai)
#pragma unroll
            for (int m = 0; m < 4; ++m) { bf16_t* rowp = base + (size_t)(row0 + ai * HALF + m * 16) * ldc + col0;
#pragma unroll
                for (int bj = 0; bj < 2; ++bj) { f32x4 v0 = acc[ai][bj][m][0] + bv[bj][0], v1 = acc[ai][bj][m][1] + bv[bj][1];
                    if (ACT == 1) { f32x2 a = gelu_pk((f32x2){v0[0], v0[1]}), b = gelu_pk((f32x2){v0[2], v0[3]}), c = gelu_pk((f32x2){v1[0], v1[1]}), d = gelu_pk((f32x2){v1[2], v1[3]});
                        v0 = (f32x4){a.x, a.y, b.x, b.y}; v1 = (f32x4){c.x, c.y, d.x, d.y}; }
                    v0 = v0 * sc; v1 = v1 * sc; u32x4 w; w.x = cvt_pk_bf16(v0[0], v0[1]); w.y = cvt_pk_bf16(v0[2], v0[3]); w.z = cvt_pk_bf16(v1[0], v1[1]); w.w = cvt_pk_bf16(v1[2], v1[3]);
                    *(u32x4*)(rowp + bj * HALF) = w; } }
    }
};
__device__ __forceinline__ float bf_lo(unsigned w) { return __uint_as_float(w << 16); }
__device__ __forceinline__ float bf_hi(unsigned w) { return __uint_as_float(w & 0xffff0000u); }
__device__ __forceinline__ float sigmoid_f(float v) { return __builtin_amdgcn_rcpf(1.0f + __expf(-v)); }
__device__ __forceinline__ float rstd_of(const float* p) { const float s = *p; return 1.0f / sqrtf(s * (1.0f / 1024.0f) + 1e-6f); }
struct EpiQkvF {
    static constexpr bool PERM = true, AFTER_DRAIN = false, APERM = false;
    bf16_t* O; size_t split_stride; float scale0; const float* bfg; float* nlf; const float* rs; const float* sw;
    __device__ __forceinline__ void operator()(const f32x4 (&acc)[2][2][4][2], const Unit& u, int wr, int wc, int fr, int fq) const {
        float rstd[2][4];
#pragma unroll
        for (int ai = 0; ai < 2; ++ai)
#pragma unroll
            for (int m = 0; m < 4; ++m) rstd[ai][m] = rstd_of(rs + u.pm * BM + ai * HALF + wr * 64 + m * 16 + fr);
        const float* swp = sw + (size_t)(u.pm >> 5) * 3328 + u.pn * BM + wc * 32 + 8 * fq;
        if (u.pn == 12) {
            if (wc == 0 && fq < 2) {
#pragma unroll
                for (int ai = 0; ai < 2; ++ai)
#pragma unroll
                    for (int m = 0; m < 4; ++m) { const int row = u.pm * BM + ai * HALF + wr * 64 + m * 16 + fr; const int b = row >> 13, t = row & 8191;
#pragma unroll
                        for (int n = 0; n < 2; ++n)
#pragma unroll
                            for (int j = 0; j < 4; ++j) { const int h = 8 * fq + 4 * n + j; const float x = acc[ai][0][m][n][j] * rstd[ai][m] + swp[4 * n + j] + bfg[h];
                                const float e = __expf(-x); const float sp = (e < 1e-3f) ? e * (1.0f - e * (0.5f - e * 0.33333333f)) : __logf(1.0f + e);
                                nlf[(size_t)(b * 16 + h) * 8192 + t] = sp * 1.4426950408889634f; } }
            }
            return;
        }
        const int row0 = u.pm * BM + wr * 64 + fr; const int t = u.pn >> 2; bf16_t* base = O + (size_t)t * split_stride; const int colt = (u.pn & 3) * BM;
        const float sc = (t == 0) ? scale0 : 1.0f;
        const int col0 = colt + wc * 32 + 8 * fq;
#pragma unroll
        for (int ai = 0; ai < 2; ++ai)
#pragma unroll
            for (int m = 0; m < 4; ++m) { bf16_t* rowp = base + (size_t)(row0 + ai * HALF + m * 16) * 1024 + col0;
#pragma unroll
                for (int bj = 0; bj < 2; ++bj) { const f32x4 s0 = *(const f32x4*)(swp + bj * HALF), s1 = *(const f32x4*)(swp + bj * HALF + 4);
                    f32x4 v0 = (acc[ai][bj][m][0] * rstd[ai][m] + s0) * sc, v1 = (acc[ai][bj][m][1] * rstd[ai][m] + s1) * sc;
                    u32x4 w; w.x = cvt_pk_bf16(v0[0], v0[1]); w.y = cvt_pk_bf16(v0[2], v0[3]); w.z = cvt_pk_bf16(v1[0], v1[1]); w.w = cvt_pk_bf16(v1[2], v1[3]);
                    *(u32x4*)(rowp + bj * HALF) = w; } }
    }
};
struct EpiGlu {
    static constexpr bool PERM = true, AFTER_DRAIN = false, APERM = false;
    const bf16_t* Y; bf16_t* Z; int ldc;
    __device__ __forceinline__ void operator()(const f32x4 (&acc)[2][2][4][2], const Unit& u, int wr, int wc, int fr, int fq) const {
        const int row0 = u.pm * BM + wr * 64 + fr, col0 = u.pn * BM + wc * 32 + 8 * fq;
#pragma unroll
        for (int ai = 0; ai < 2; ++ai)
#pragma unroll
            for (int m = 0; m < 4; ++m) { const size_t off = (size_t)(row0 + ai * HALF + m * 16) * ldc + col0;
#pragma unroll
                for (int bj = 0; bj < 2; ++bj) { const u32x4 yv = *(const u32x4*)(Y + off + bj * HALF); const f32x4 v0 = acc[ai][bj][m][0], v1 = acc[ai][bj][m][1];
                    u32x4 w;
                    w.x = cvt_pk_bf16(bf_lo(yv.x) * sigmoid_f(v0[0]), bf_hi(yv.x) * sigmoid_f(v0[1]));
                    w.y = cvt_pk_bf16(bf_lo(yv.y) * sigmoid_f(v0[2]), bf_hi(yv.y) * sigmoid_f(v0[3]));
                    w.z = cvt_pk_bf16(bf_lo(yv.z) * sigmoid_f(v1[0]), bf_hi(yv.z) * sigmoid_f(v1[1]));
                    w.w = cvt_pk_bf16(bf_lo(yv.w) * sigmoid_f(v1[2]), bf_hi(yv.w) * sigmoid_f(v1[3]));
                    *(u32x4*)(Z + off + bj * HALF) = w; } }
    }
};
__device__ __forceinline__ f32x4 dpp_ror1(f32x4 v) { f32x4 r;
#pragma unroll
    for (int j = 0; j < 4; ++j) r[j] = __int_as_float(__builtin_amdgcn_update_dpp(0, __float_as_int(v[j]), 0x121, 0xF, 0xF, true));
    return r; }
__device__ __forceinline__ f32x4 silu4_mul(f32x4 c, f32x4 b) { f32x4 r;
#pragma unroll
    for (int j = 0; j < 4; ++j) r[j] = c[j] * __builtin_amdgcn_rcpf(1.0f + __expf(-c[j])) * b[j];
    return r; }
struct EpiConvGate {
    static constexpr bool PERM = true, AFTER_DRAIN = false, APERM = true;
    bf16_t* G; float* fixa; float* fixb; float* halo; const float* cw; const float* cb; int FFn; const float* rs; const float* sw;
    __device__ __forceinline__ void operator()(const f32x4 (&acc)[2][2][4][2], const Unit& u, int wr, int wc, int fr, int fq) const {
        typedef unsigned u32x2 __attribute__((ext_vector_type(2)));
        const int f0 = u.pn * HALF + wc * 32 + 8 * fq;
        float rstd[2][4];
#pragma unroll
        for (int ai = 0; ai < 2; ++ai)
#pragma unroll
            for (int m = 0; m < 4; ++m) rstd[ai][m] = rstd_of(rs + u.pm * BM + ai * HALF + wr * 64 + 4 * fr + m);
        const float* swp = sw + (size_t)(u.pm >> 5) * 2 * FFn + u.pn * BM + wc * 32 + 8 * fq;
#pragma unroll
        for (int n = 0; n < 2; ++n) { const int f = f0 + 4 * n; const f32x4 sa = *(const f32x4*)(swp + 4 * n), sb = *(const f32x4*)(swp + HALF + 4 * n);
            const f32x4 w0 = *(const f32x4*)(cw + f), w1 = *(const f32x4*)(cw + FFn + f), w2 = *(const f32x4*)(cw + 2 * FFn + f), wb = *(const f32x4*)(cb + f);
#pragma unroll
            for (int ai = 0; ai < 2; ++ai) { const int rowbase = u.pm * BM + ai * HALF + wr * 64, sp = rowbase >> 6;
                const f32x4 a0 = acc[ai][0][0][n] * rstd[ai][0] + sa, a1 = acc[ai][0][1][n] * rstd[ai][1] + sa, a2 = acc[ai][0][2][n] * rstd[ai][2] + sa, a3 = acc[ai][0][3][n] * rstd[ai][3] + sa;
                const f32x4 b0 = acc[ai][1][0][n] * rstd[ai][0] + sb, b1 = acc[ai][1][1][n] * rstd[ai][1] + sb, b2 = acc[ai][1][2][n] * rstd[ai][2] + sb, b3 = acc[ai][1][3][n] * rstd[ai][3] + sb;
                const f32x4 d3 = dpp_ror1(a3), d2 = dpp_ror1(a2);
                const f32x4 g0 = silu4_mul(wb + w0 * d2 + w1 * d3 + w2 * a0, b0);
                const f32x4 g1 = silu4_mul(wb + w0 * d3 + w1 * a0 + w2 * a1, b1);
                const f32x4 g2 = silu4_mul(wb + w0 * a0 + w1 * a1 + w2 * a2, b2);
                const f32x4 g3 = silu4_mul(wb + w0 * a1 + w1 * a2 + w2 * a3, b3);
                bf16_t* gp = G + (size_t)(rowbase + 4 * fr) * FFn + f;
                if (fr != 0) { u32x2 w; w.x = cvt_pk_bf16(g0[0], g0[1]); w.y = cvt_pk_bf16(g0[2], g0[3]); *(u32x2*)gp = w;
                               w.x = cvt_pk_bf16(g1[0], g1[1]); w.y = cvt_pk_bf16(g1[2], g1[3]); *(u32x2*)(gp + FFn) = w; }
                else { float* fa = fixa + (size_t)(sp * 2) * FFn + f; float* fb = fixb + (size_t)(sp * 2) * FFn + f;
                       *(f32x4*)fa = a0; *(f32x4*)(fa + FFn) = a1; *(f32x4*)fb = b0; *(f32x4*)(fb + FFn) = b1; }
                { u32x2 w; w.x = cvt_pk_bf16(g2[0], g2[1]); w.y = cvt_pk_bf16(g2[2], g2[3]); *(u32x2*)(gp + 2 * FFn) = w;
                  w.x = cvt_pk_bf16(g3[0], g3[1]); w.y = cvt_pk_bf16(g3[2], g3[3]); *(u32x2*)(gp + 3 * FFn) = w; }
                if (fr == 15) { float* hp = halo + (size_t)(sp * 2) * FFn + f; *(f32x4*)hp = a2; *(f32x4*)(hp + FFn) = a3; }
            } }
    }
};
template <bool BB  > struct EpiResNorm {
    static constexpr bool PERM = true, AFTER_DRAIN = false, APERM = false;
    const void* base; bf16_t* out; int ldc; const float* gate; int gstride; const float* gn; const float* scl; bf16_t* HB; float* rss;
    __device__ __forceinline__ void operator()(const f32x4 (&acc)[2][2][4][2], const Unit& u, int wr, int wc, int fr, int fq) const {
        const int col0 = u.pn * BM + wc * 32 + 8 * fq; const float* gp = gate + (size_t)(u.pm >> 5) * gstride + col0; const float* sp = scl + (size_t)(u.pm >> 5) * gstride + col0;
        f32x4 gv[2][2], gs[2][2];
#pragma unroll
        for (int bj = 0; bj < 2; ++bj)
#pragma unroll
            for (int n = 0; n < 2; ++n) { gv[bj][n] = *(const f32x4*)(gp + bj * HALF + n * 4); gs[bj][n] = *(const f32x4*)(gn + col0 + bj * HALF + n * 4) * (*(const f32x4*)(sp + bj * HALF + n * 4) + 1.0f); }
#pragma unroll
        for (int ai = 0; ai < 2; ++ai)
#pragma unroll
            for (int m = 0; m < 4; ++m) { const int row = u.pm * BM + ai * HALF + wr * 64 + m * 16 + fr; const size_t off = (size_t)row * ldc + col0; float ss = 0.f;
#pragma unroll
                for (int bj = 0; bj < 2; ++bj) { f32x4 bs0, bs1;
                    if (BB) { const u32x4 q = *(const u32x4*)((const bf16_t*)base + off + bj * HALF); bs0 = (f32x4){bf_lo(q.x), bf_hi(q.x), bf_lo(q.y), bf_hi(q.y)}; bs1 = (f32x4){bf_lo(q.z), bf_hi(q.z), bf_lo(q.w), bf_hi(q.w)}; }
                    else { bs0 = *(const f32x4*)((const float*)base + off + bj * HALF); bs1 = *(const f32x4*)((const float*)base + off + bj * HALF + 4); }
                    const f32x4 o0 = bs0 + gv[bj][0] * acc[ai][bj][m][0], o1 = bs1 + gv[bj][1] * acc[ai][bj][m][1];
                    { u32x4 wo; wo.x = cvt_pk_bf16(o0[0], o0[1]); wo.y = cvt_pk_bf16(o0[2], o0[3]); wo.z = cvt_pk_bf16(o1[0], o1[1]); wo.w = cvt_pk_bf16(o1[2], o1[3]); __builtin_nontemporal_store(wo, (u32x4*)(out + off + bj * HALF)); }
                    ss += ((o0[0] * o0[0] + o0[1] * o0[1]) + (o0[2] * o0[2] + o0[3] * o0[3])) + ((o1[0] * o1[0] + o1[1] * o1[1]) + (o1[2] * o1[2] + o1[3] * o1[3]));
                    const f32x4 h0 = o0 * gs[bj][0], h1 = o1 * gs[bj][1]; u32x4 w; w.x = cvt_pk_bf16(h0[0], h0[1]); w.y = cvt_pk_bf16(h0[2], h0[3]); w.z = cvt_pk_bf16(h1[0], h1[1]); w.w = cvt_pk_bf16(h1[2], h1[3]);
                    *(u32x4*)(HB + off + bj * HALF) = w; }
                ss += __shfl_xor(ss, 16); ss += __shfl_xor(ss, 32);
                if (fq == 0) unsafeAtomicAdd(rss + row, ss);
                if (m & 1) asm volatile("" ::: "memory"); }
    }
};
struct EpiRes {
    static constexpr bool PERM = false, AFTER_DRAIN = false, APERM = false;
    const float* base; float* out; int ldc; const float* gate; int gstride;
    __device__ __forceinline__ void operator()(const f32x4 (&acc)[2][2][4][2], const Unit& u, int wr, int wc, int fr, int fq) const {
        const int col0 = u.pn * BM + wc * 32 + 4 * fq; const float* gp = gate + (size_t)(u.pm >> 5) * gstride + col0;
        f32x4 gv[2][2];
#pragma unroll
        for (int bj = 0; bj < 2; ++bj)
#pragma unroll
            for (int n = 0; n < 2; ++n) gv[bj][n] = *(const f32x4*)(gp + bj * HALF + n * 16);
#pragma unroll
        for (int ai = 0; ai < 2; ++ai)
#pragma unroll
            for (int m = 0; m < 4; ++m) { const size_t off = (size_t)(u.pm * BM + ai * HALF + wr * 64 + m * 16 + fr) * ldc + col0;
#pragma unroll
                for (int bj = 0; bj < 2; ++bj)
#pragma unroll
                    for (int n = 0; n < 2; ++n) { const f32x4 bs = *(const f32x4*)(base + off + bj * HALF + n * 16);
                        *(f32x4*)(out + off + bj * HALF + n * 16) = bs + gv[bj][n] * acc[ai][bj][m][n]; }
                if (m & 1) asm volatile("" ::: "memory"); }
    }
};
struct EpiResFinal {
    static constexpr bool PERM = true, AFTER_DRAIN = true, APERM = false;
    const bf16_t* base; float* out; int ldc; const float* gate; int gstride; const float* gfin; unsigned* xbuf; unsigned* cnt;
    __device__ __forceinline__ void fused(f32x4 (&acc)[2][2][4][2], const Unit& u, int wr, int wc, int fr, int fq, PG8_LAS unsigned char* lds, int wid, int lane) const {
        PG8_LAS float* P = (PG8_LAS float*)lds; PG8_LAS float* S = (PG8_LAS float*)(lds + 8192);
        const int col0 = u.pn * BM + wc * 32 + 8 * fq; const float* gp = gate + (size_t)(u.pm >> 5) * gstride + col0;
        f32x4 gv[2][2];
#pragma unroll
        for (int bj = 0; bj < 2; ++bj)
#pragma unroll
            for (int n = 0; n < 2; ++n) gv[bj][n] = *(const f32x4*)(gp + bj * HALF + n * 4);
#pragma unroll
        for (int ai = 0; ai < 2; ++ai)
#pragma unroll
            for (int m = 0; m < 4; ++m) { const int r = ai * HALF + wr * 64 + m * 16 + fr; const size_t off = (size_t)(u.pm * BM + r) * ldc + col0; float ss = 0.f;
#pragma unroll
                for (int bj = 0; bj < 2; ++bj) { const u32x4 q = *(const u32x4*)(base + off + bj * HALF);
                    const f32x4 o0 = (f32x4){bf_lo(q.x), bf_hi(q.x), bf_lo(q.y), bf_hi(q.y)} + gv[bj][0] * acc[ai][bj][m][0], o1 = (f32x4){bf_lo(q.z), bf_hi(q.z), bf_lo(q.w), bf_hi(q.w)} + gv[bj][1] * acc[ai][bj][m][1];
                    acc[ai][bj][m][0] = o0; acc[ai][bj][m][1] = o1;
                    ss += ((o0[0] * o0[0] + o0[1] * o0[1]) + (o0[2] * o0[2] + o0[3] * o0[3])) + ((o1[0] * o1[0] + o1[1] * o1[1]) + (o1[2] * o1[2] + o1[3] * o1[3])); }
                ss += __shfl_xor(ss, 16); ss += __shfl_xor(ss, 32);
                if (fq == 0) P[r * 4 + wc] = ss;
                if (m & 1) asm volatile("" ::: "memory"); }
        asm volatile("s_waitcnt lgkmcnt(0)" ::: "memory"); __builtin_amdgcn_s_barrier(); asm volatile("" ::: "memory");
        const int row = wid * 32 + (lane & 31);
        if (lane < 32) { const float tot = (P[row * 4 + 0] + P[row * 4 + 1]) + (P[row * 4 + 2] + P[row * 4 + 3]);
            __hip_atomic_store(xbuf + ((size_t)(u.pm * BM + row) * 4 + u.pn), __float_as_uint(tot), __ATOMIC_RELAXED, __HIP_MEMORY_SCOPE_AGENT); }
        asm volatile("s_waitcnt vmcnt(0)" ::: "memory");
        if (lane == 0) __hip_atomic_fetch_add(cnt + 64 * u.pm, 1u, __ATOMIC_RELAXED, __HIP_MEMORY_SCOPE_AGENT);
        if (wid == 0) { for (unsigned sp = 0; sp < (1u << 24); ++sp) { if ((unsigned)__builtin_amdgcn_readfirstlane(__hip_atomic_load(cnt + 64 * u.pm, __ATOMIC_RELAXED, __HIP_MEMORY_SCOPE_AGENT)) >= 32u) break; __builtin_amdgcn_s_sleep(2); }
            __builtin_amdgcn_fence(__ATOMIC_ACQUIRE, "agent"); }
        asm volatile("s_waitcnt vmcnt(0) lgkmcnt(0)" ::: "memory"); __builtin_amdgcn_s_barrier(); asm volatile("" ::: "memory");
        if (lane < 32) { const unsigned* sl = xbuf + (size_t)(u.pm * BM + row) * 4; float q = 0.f;
#pragma unroll
            for (int t = 0; t < 4; ++t) q += __uint_as_float(__hip_atomic_load(sl + t, __ATOMIC_RELAXED, __HIP_MEMORY_SCOPE_AGENT));
            S[row] = 1.0f / sqrtf(q * (1.0f / 1024.0f) + 1e-6f); }
        asm volatile("s_waitcnt lgkmcnt(0)" ::: "memory"); __builtin_amdgcn_s_barrier(); asm volatile("" ::: "memory");
        f32x4 gf[2][2];
#pragma unroll
        for (int bj = 0; bj < 2; ++bj)
#pragma unroll
            for (int n = 0; n < 2; ++n) gf[bj][n] = *(const f32x4*)(gfin + col0 + bj * HALF + n * 4);
#pragma unroll
        for (int ai = 0; ai < 2; ++ai)
#pragma unroll
            for (int m = 0; m < 4; ++m) { const int r = ai * HALF + wr * 64 + m * 16 + fr; const size_t off = (size_t)(u.pm * BM + r) * ldc + col0; const float rstd = S[r];
#pragma unroll
                for (int bj = 0; bj < 2; ++bj)
#pragma unroll
                    for (int n = 0; n < 2; ++n) __builtin_nontemporal_store(acc[ai][bj][m][n] * rstd * gf[bj][n], (f32x4*)(out + off + bj * HALF + n * 4)); }
    }
};
template <class Epi, class Sched, bool ALIGN_EPI = false, bool SP2 = false>
__device__ __forceinline__ void gemm_phase(PG8_LAS unsigned char* lds, const Gemm g, const Sched& S, const Epi& E) {
    const int tid = opaque_tid(), wid = __builtin_amdgcn_readfirstlane(tid >> 6), lane = tid & 63, wr = wid >> 2, wc = wid & 3, fr = lane & 15, fq = lane >> 4;
    const int K = g.K, nt = K / BK, lda = g.lda;
    unsigned voffA[2], voffB[2];
#pragma unroll
    for (int i = 0; i < 2; ++i) { int R, C; stage_rc(tid * 16 + i * 8192, R, C); const int Rb = Epi::PERM ? ((R & ~31) + perm32(R & 31)) : R;
        const int Ra = Epi::APERM ? ((R & ~63) + 4 * (R & 15) + ((R >> 4) & 3)) : R;
        voffA[i] = (unsigned)(Ra * lda + C) * 2u; voffB[i] = (unsigned)(Rb * K + C) * 2u; }
    const size_t kstep = (size_t)(BK * 2);
    const size_t hstepA = (size_t)HALF * lda * 2, hstepB = (size_t)HALF * K * 2;
    const size_t tstepA = 2 * hstepA, tstepB = 2 * hstepB;
    const unsigned ldsw = (unsigned)wid * 1024u;
    const int aoff = lds_byte(wr * 64 + fr, fq * 8), boff = lds_byte(wc * 32 + fr, fq * 8);
#define PG8_SA(b, h) (((b) * 2 + (h)) * HTB)
#define PG8_SB(b, h) ((4 + (b) * 2 + (h)) * HTB)
#define PG8_STAGE(bufoff, gbase, voff) do { _Pragma("unroll") for (int _i = 0; _i < 2; ++_i) \
        __builtin_amdgcn_global_load_lds((const unsigned*)((const char*)(gbase) + (voff)[_i]), (PG8_LAS unsigned*)(lds + (bufoff) + ldsw + _i * 8192), 16, 0, 0); } while (0)
#define PG8_LDA(dst, b, h) do { _Pragma("unroll") for (int m = 0; m < 4; ++m) _Pragma("unroll") for (int k = 0; k < 2; ++k) dst[m][k] = *(const PG8_LAS bf16x8*)(lds + PG8_SA(b, h) + aoff + m * 2048 + k * 1024); } while (0)
#define PG8_LDB(dst, b, h) do { _Pragma("unroll") for (int n = 0; n < 2; ++n) _Pragma("unroll") for (int k = 0; k < 2; ++k) dst[n][k] = *(const PG8_LAS bf16x8*)(lds + PG8_SB(b, h) + boff + n * 2048 + k * 1024); } while (0)
#define PG8_MMA(ai, bj, At, Bt) do { __builtin_amdgcn_s_setprio(1); _Pragma("unroll") for (int m = 0; m < 4; ++m) _Pragma("unroll") for (int n = 0; n < 2; ++n) _Pragma("unroll") for (int k = 0; k < 2; ++k) \
        acc[ai][bj][m][n] = __builtin_amdgcn_mfma_f32_16x16x32_bf16(Bt[n][k], At[m][k], acc[ai][bj][m][n], 0, 0, 0); __builtin_amdgcn_s_setprio(0); } while (0)
#define PG8_WAIT_V(n) asm volatile("s_waitcnt vmcnt(" #n ")" ::: "memory")
#define PG8_WAIT_L(n) asm volatile("s_waitcnt lgkmcnt(" #n ")" ::: "memory")
#define PG8_BAR __builtin_amdgcn_s_barrier()
#define PG8_SCHED __builtin_amdgcn_sched_barrier(0)
    Unit cur, nxt; int ui = 0;
    if (!S.next(0, cur)) return;
    f32x4 acc[2][2][4][2];
#pragma unroll
    for (int a = 0; a < 2; ++a)
#pragma unroll
        for (int b = 0; b < 2; ++b)
#pragma unroll
            for (int m = 0; m < 4; ++m)
#pragma unroll
                for (int n = 0; n < 2; ++n) acc[a][b][m][n] = (f32x4){0.f, 0.f, 0.f, 0.f};
    bf16x8 At[4][2], B0[2][2], B1[2][2];
    const char* cA = (const char*)g.A + (size_t)cur.pm * tstepA; const char* cB = (const char*)g.Bt + (size_t)cur.pn * tstepB;
    S.a_ready(cur);
    if constexpr (SP2) {
        PG8_STAGE(PG8_SB(0, 0), cB, voffB); PG8_STAGE(PG8_SB(0, 1), cB + hstepB, voffB); PG8_STAGE(PG8_SA(0, 0), cA, voffA); PG8_STAGE(PG8_SA(0, 1), cA + hstepA, voffA);
        if (wr == 1) PG8_BAR;
        PG8_WAIT_V(2); PG8_BAR;
        PG8_STAGE(PG8_SB(1, 0), cB + kstep, voffB); PG8_STAGE(PG8_SA(1, 0), cA + kstep, voffA); PG8_STAGE(PG8_SB(1, 1), cB + hstepB + kstep, voffB);
        PG8_WAIT_V(6); PG8_BAR;
    } else {
        PG8_STAGE(PG8_SB(0, 0), cB, voffB); PG8_STAGE(PG8_SA(0, 0), cA, voffA); PG8_STAGE(PG8_SB(0, 1), cB + hstepB, voffB); PG8_STAGE(PG8_SA(0, 1), cA + hstepA, voffA);
        if (wr == 1) PG8_BAR;
        PG8_WAIT_V(4); PG8_BAR;
        PG8_STAGE(PG8_SB(1, 0), cB + kstep, voffB); PG8_STAGE(PG8_SA(1, 0), cA + kstep, voffA); PG8_STAGE(PG8_SB(1, 1), cB + hstepB + kstep, voffB);
        PG8_WAIT_V(6); PG8_BAR;
    }
    for (;;) {
        const bool has_next = S.next(ui + 1, nxt);
        const char* nA = has_next ? (const char*)g.A + (size_t)nxt.pm * tstepA : cA; const char* nB = has_next ? (const char*)g.Bt + (size_t)nxt.pn * tstepB : cB;
        for (int t = 0; t < nt; t += 2) {
            const bool last = (t == nt - 2);
            const char* a1 = cA + (size_t)(t + 1) * kstep;
            const char* a2 = last ? nA : cA + (size_t)(t + 2) * kstep; const char* b2 = last ? nB : cB + (size_t)(t + 2) * kstep;
            const char* a3 = a2 + kstep; const char* b3 = b2 + kstep;
            if (last && has_next) S.a_ready(nxt);
            if constexpr (SP2) {
            PG8_LDB(B0, 0, 0); PG8_LDB(B1, 0, 1); PG8_SCHED; PG8_LDA(At, 0, 0); PG8_STAGE(PG8_SA(1, 1), a1 + hstepA, voffA);
            PG8_WAIT_V(8); PG8_WAIT_L(0); PG8_BAR; PG8_MMA(0, 0, At, B0); PG8_MMA(0, 1, At, B1); PG8_BAR; PG8_SCHED;
            PG8_LDA(At, 0, 1); PG8_STAGE(PG8_SB(0, 0), b2, voffB); PG8_STAGE(PG8_SB(0, 1), b2 + hstepB, voffB); PG8_STAGE(PG8_SA(0, 0), a2, voffA);
            PG8_WAIT_V(8); PG8_WAIT_L(0); PG8_BAR; PG8_MMA(1, 0, At, B0); PG8_MMA(1, 1, At, B1); PG8_BAR; PG8_SCHED;
            PG8_LDB(B0, 1, 0); PG8_LDB(B1, 1, 1); PG8_SCHED; PG8_LDA(At, 1, 0); PG8_STAGE(PG8_SA(0, 1), a2 + hstepA, voffA);
            PG8_WAIT_V(8); PG8_WAIT_L(0); PG8_BAR; PG8_MMA(0, 0, At, B0); PG8_MMA(0, 1, At, B1); PG8_BAR; PG8_SCHED;
            PG8_LDA(At, 1, 1); PG8_STAGE(PG8_SB(1, 0), b3, voffB); PG8_STAGE(PG8_SB(1, 1), b3 + hstepB, voffB); PG8_STAGE(PG8_SA(1, 0), a3, voffA);
            PG8_WAIT_V(8); PG8_WAIT_L(0); PG8_BAR; PG8_MMA(1, 0, At, B0); PG8_MMA(1, 1, At, B1); PG8_BAR; PG8_SCHED;
            } else {
            PG8_LDB(B0, 0, 0); PG8_SCHED; PG8_LDA(At, 0, 0); PG8_STAGE(PG8_SA(1, 1), a1 + hstepA, voffA);
            PG8_WAIT_L(8); PG8_BAR; PG8_WAIT_L(0); PG8_MMA(0, 0, At, B0); PG8_BAR; PG8_SCHED;
            PG8_LDB(B1, 0, 1); PG8_STAGE(PG8_SB(0, 0), b2, voffB);
            PG8_BAR; PG8_WAIT_L(0); PG8_MMA(0, 1, At, B1); PG8_BAR;
            PG8_LDA(At, 0, 1); PG8_STAGE(PG8_SA(0, 0), a2, voffA);
            PG8_BAR; PG8_WAIT_L(0); PG8_MMA(1, 0, At, B0); PG8_BAR; PG8_SCHED;
            PG8_STAGE(PG8_SB(0, 1), b2 + hstepB, voffB);
            PG8_WAIT_V(6); PG8_BAR; PG8_MMA(1, 1, At, B1); PG8_BAR;
            PG8_LDB(B0, 1, 0); PG8_SCHED; PG8_LDA(At, 1, 0); PG8_STAGE(PG8_SA(0, 1), a2 + hstepA, voffA);
            PG8_WAIT_L(8); PG8_BAR; PG8_WAIT_L(0); PG8_MMA(0, 0, At, B0); PG8_BAR; PG8_SCHED;
            PG8_LDB(B1, 1, 1); PG8_STAGE(PG8_SB(1, 0), b3, voffB);
            PG8_BAR; PG8_WAIT_L(0); PG8_MMA(0, 1, At, B1); PG8_BAR;
            PG8_LDA(At, 1, 1); PG8_STAGE(PG8_SA(1, 0), a3, voffA);
            PG8_BAR; PG8_WAIT_L(0); PG8_MMA(1, 0, At, B0); PG8_BAR; PG8_SCHED;
            PG8_STAGE(PG8_SB(1, 1), b3 + hstepB, voffB);
            PG8_WAIT_V(6); PG8_BAR; PG8_MMA(1, 1, At, B1); PG8_BAR;
            }
        }
        if constexpr (ALIGN_EPI) { if (wr == 0) PG8_BAR; }
        if constexpr (!Epi::AFTER_DRAIN) { E(acc, cur, wr, wc, fr, fq); S.done(cur); }
        if (!has_next) break;
#pragma unroll
        for (int a = 0; a < 2; ++a)
#pragma unroll
            for (int b = 0; b < 2; ++b)
#pragma unroll
                for (int m = 0; m < 4; ++m)
#pragma unroll
                    for (int n = 0; n < 2; ++n) acc[a][b][m][n] = (f32x4){0.f, 0.f, 0.f, 0.f};
        cur = nxt; cA = nA; cB = nB; ++ui;
        if constexpr (ALIGN_EPI) { if (wr == 1) PG8_BAR; }
    }
    PG8_WAIT_V(0);
    if constexpr (!ALIGN_EPI) { if (wr == 0) PG8_BAR; }
    PG8_BAR;
    if constexpr (Epi::AFTER_DRAIN) { E.fused(acc, cur, wr, wc, fr, fq, lds, wid, lane); S.done(cur); }
#undef PG8_SA
#undef PG8_SB
#undef PG8_STAGE
#undef PG8_LDA
#undef PG8_LDB
#undef PG8_MMA
#undef PG8_WAIT_V
#undef PG8_WAIT_L
#undef PG8_BAR
#undef PG8_SCHED
}
}
#include <hip/hip_bf16.h>
#include <cmath>
namespace attn_body {
using bf16=__hip_bfloat16;
using bf16x8=__attribute__((ext_vector_type(8)))short;
using s16x4=__attribute__((ext_vector_type(4)))short;
using f32x16=__attribute__((ext_vector_type(16)))float;
using u32x4=__attribute__((ext_vector_type(4)))unsigned;
using f32x4v=__attribute__((ext_vector_type(4)))float;
constexpr int BATCH=2,NHEAD=16,SEQ=8192,D=64,DM=NHEAD*D;
constexpr int NW=8,QBLK=32,QB=QBLK*NW,KVBLK=64,NQB=SEQ/QB;
constexpr int ATTN_PITCH=DM, ATTN_UNIT_ROWS=QB;
__device__ __forceinline__ int crow(int r,int hi){return (r&3)+8*(r>>2)+4*hi;}
#define SBAR() __builtin_amdgcn_sched_barrier(0)
__device__ __forceinline__ void cmask(f32x16&p0,f32x16&p1,int jb,int qrel,int hi){
  const float NEG=-INFINITY; int kb=64*jb+4*hi;
  #pragma unroll
  for(int r=0;r<16;++r){int kv=kb+(r&3)+8*(r>>2); if(kv>qrel)p0[r]=NEG; if(kv+32>qrel)p1[r]=NEG;}
}

constexpr int NSLOT=3, SLOTB=8192;
constexpr int LDS_K=0, LDS_V=NSLOT*SLOTB, LDS_WS=2*NSLOT*SLOTB, LDS_OST=LDS_WS+NW*64*4, LDS_FB=LDS_OST+NW*4096, LDS_BYTES=LDS_FB+SEQ*4;
constexpr float C2=0.125f*1.4426950408889634f;
__device__ __forceinline__ void glds16(const void*gsrc,unsigned lds_dst){unsigned keep;
  asm volatile("s_mov_b32 %0, m0\n\ts_mov_b32 m0, %2\n\ts_nop 0\n\tglobal_load_lds_dwordx4 %1, off\n\ts_mov_b32 m0, %0":"=&s"(keep):"v"(gsrc),"s"(lds_dst):"memory");}
__device__ __forceinline__ float max3f(float a,float b,float c){float r;asm("v_max3_f32 %0, %1, %2, %3":"=v"(r):"v"(a),"v"(b),"v"(c));return r;}
__device__ __forceinline__ float max2f(float a,float b){float r;asm("v_max_f32_e32 %0, %1, %2":"=v"(r):"v"(a),"v"(b));return r;}
__device__ __forceinline__ float fadd_s(float a,float b){float r;asm("v_add_f32_e32 %0, %1, %2":"=v"(r):"v"(a),"v"(b));return r;}
__device__ __forceinline__ float fsub_s(float a,float b){float r;asm("v_sub_f32_e32 %0, %1, %2":"=v"(r):"v"(a),"v"(b));return r;}
typedef float f32x2_t __attribute__((ext_vector_type(2))); typedef __bf16 bf16x2_t __attribute__((ext_vector_type(2)));
__device__ __forceinline__ unsigned cvtpk_s(float lo,float hi){f32x2_t v={lo,hi};bf16x2_t b=__builtin_convertvector(v,bf16x2_t);return __builtin_bit_cast(unsigned,b);}
#define WAIT_BAR(N) asm volatile("s_waitcnt vmcnt(" #N ") lgkmcnt(0)\n\ts_barrier":::"memory")

__device__ __forceinline__ void qkt(f32x16&p0,f32x16&p1,const char*Kslot,const bf16x8*qr,const f32x16&c0in,const f32x16&c1in,int r32,int hi){
  const char*kb=Kslot+hi*1024+r32*16;
  #pragma unroll
  for(int d0=0;d0<4;++d0){
    const bf16x8 b0=*reinterpret_cast<const bf16x8*>(kb+d0*2048);
    const bf16x8 b1=*reinterpret_cast<const bf16x8*>(kb+d0*2048+512);
    if(d0==0){p0=__builtin_amdgcn_mfma_f32_32x32x16_bf16(b0,qr[0],c0in,0,0,0);p1=__builtin_amdgcn_mfma_f32_32x32x16_bf16(b1,qr[0],c1in,0,0,0);}
    else{p0=__builtin_amdgcn_mfma_f32_32x32x16_bf16(b0,qr[d0],p0,0,0,0);p1=__builtin_amdgcn_mfma_f32_32x32x16_bf16(b1,qr[d0],p1,0,0,0);}}
}
typedef __attribute__((address_space(3))) const char* lds_cptr;
typedef short v4i16_t __attribute__((ext_vector_type(4)));
__device__ __forceinline__ void kload8(bf16x8*kf,lds_cptr kp){
  kf[0]=*(const __attribute__((address_space(3))) bf16x8*)(kp);      kf[1]=*(const __attribute__((address_space(3))) bf16x8*)(kp+512);
  kf[2]=*(const __attribute__((address_space(3))) bf16x8*)(kp+2048); kf[3]=*(const __attribute__((address_space(3))) bf16x8*)(kp+2560);
  kf[4]=*(const __attribute__((address_space(3))) bf16x8*)(kp+4096); kf[5]=*(const __attribute__((address_space(3))) bf16x8*)(kp+4608);
  kf[6]=*(const __attribute__((address_space(3))) bf16x8*)(kp+6144); kf[7]=*(const __attribute__((address_space(3))) bf16x8*)(kp+6656);
}
__device__ __forceinline__ void kload2(bf16x8*kf,lds_cptr kp,int j){ kf[2*j]=*(const __attribute__((address_space(3))) bf16x8*)(kp+j*2048); kf[2*j+1]=*(const __attribute__((address_space(3))) bf16x8*)(kp+j*2048+512); }
__device__ __forceinline__ s16x4 vtr(lds_cptr p){ return __builtin_bit_cast(s16x4,__builtin_amdgcn_ds_read_tr16_b64_v4i16((__attribute__((address_space(3))) v4i16_t*)p)); }
__device__ __forceinline__ float rowmax(const f32x16&p0,const f32x16&p1){
  float a=max3f(p0[0],p0[1],p1[0]),b=max3f(p0[2],p0[3],p1[1]);a=max3f(a,p1[2],p1[3]);
  #pragma unroll
  for(int r=4;r<16;r+=4){a=max3f(a,p0[r],p0[r+1]);b=max3f(b,p0[r+2],p0[r+3]);a=max3f(a,p1[r],p1[r+1]);b=max3f(b,p1[r+2],p1[r+3]);}
  const float m=max2f(a,b);
  auto rr=__builtin_amdgcn_permlane32_swap(__float_as_uint(m),__float_as_uint(m),false,false);
  return max2f(__uint_as_float(rr[0]),__uint_as_float(rr[1]));
}
__device__ __forceinline__ void pv(f32x16*o,int vb,bf16x8 pa0,bf16x8 pa1,bf16x8 pa2,bf16x8 pa3){
  #pragma unroll
  for(int d0=0;d0<2;++d0){s16x4 lo[4],hi[4];
    #pragma unroll
    for(int ks=0;ks<4;++ks){
      asm volatile("ds_read_b64_tr_b16 %0,%1 offset:%c2":"=&v"(lo[ks]):"v"(vb),"i"(d0*4096+ks*1024):"memory");
      asm volatile("ds_read_b64_tr_b16 %0,%1 offset:%c2":"=&v"(hi[ks]):"v"(vb),"i"(d0*4096+ks*1024+512):"memory");}
    asm volatile("s_waitcnt lgkmcnt(0)":::"memory");SBAR();
    #define PK(k) (bf16x8){lo[k][0],lo[k][1],lo[k][2],lo[k][3],hi[k][0],hi[k][1],hi[k][2],hi[k][3]}
    o[d0]=__builtin_amdgcn_mfma_f32_32x32x16_bf16(pa0,PK(0),o[d0],0,0,0);
    o[d0]=__builtin_amdgcn_mfma_f32_32x32x16_bf16(pa1,PK(1),o[d0],0,0,0);
    o[d0]=__builtin_amdgcn_mfma_f32_32x32x16_bf16(pa2,PK(2),o[d0],0,0,0);
    o[d0]=__builtin_amdgcn_mfma_f32_32x32x16_bf16(pa3,PK(3),o[d0],0,0,0);
    #undef PK
  }
}

#ifndef ATTN_STORE16
#define ATTN_STORE16(p,v) (*(u32x4*)(p)=(v))
#endif
template<int THRL> __device__ __forceinline__ void attn_unit(int b,int h,int qb,const bf16*Q,const bf16*__restrict__ K,const bf16*__restrict__ V,bf16*O,const float*__restrict__ NLF,char*shm,const bool do_bias){
  const int tid=opaque_tid(),lane=tid&63,r32=lane&31,hi=lane>>5; const int wid=__builtin_amdgcn_readfirstlane(tid>>6);
  const long rowbase=(long)b*SEQ; const int q0=qb*QB;
  const bf16*Qw=Q+(rowbase+q0+wid*QBLK)*DM+h*D;
  const bf16*Kh=K+rowbase*DM+h*D,*Vh=V+rowbase*DM+h*D;
  const unsigned lds0=(unsigned)(uintptr_t)shm;
  float*wsf=(float*)(shm+LDS_WS)+wid*64;
  const bf16*ksrc=Kh+(long)lane*DM+wid*8;
  const bf16*vsrc=Vh+(long)(16*(wid&3)+(lane>>2))*DM+(wid>>2)*32+(lane&3)*8;
  const unsigned kdst=lds0+LDS_K+wid*1024, vdst=lds0+LDS_V+wid*1024;
  #define DMA_K(t,slot) glds16(ksrc+(long)(t)*KVBLK*DM,(unsigned)__builtin_amdgcn_readfirstlane(kdst+(slot)))
  #define DMA_V(t,slot) glds16(vsrc+(long)(t)*KVBLK*DM,(unsigned)__builtin_amdgcn_readfirstlane(vdst+(slot)))
  const int vb0=(int)(lds0+LDS_V)+((lane>>4)&1)*32+(lane&3)*8+(4*hi+((lane&15)>>2))*64;
  const char*Kbase=shm+LDS_K; bf16x8 kf[8];
  const lds_cptr shm3=(lds_cptr)shm; const lds_cptr kp0=shm3+LDS_K+hi*1024+r32*16; const lds_cptr vp0=shm3+LDS_V+((lane>>4)&1)*32+(lane&3)*8+(4*hi+((lane&15)>>2))*64;
  const int NT=(q0+QB)/KVBLK;
  typedef __attribute__((address_space(3))) f32x4v* lds_f4p;
  if(do_bias){ const int nkeys=SEQ; const int e0=tid*16; const bool act=e0<nkeys;
    f32x4v v0={0.f,0.f,0.f,0.f},v1=v0,v2=v0,v3=v0;
    if(act){ const f32x4v*src=reinterpret_cast<const f32x4v*>(NLF+(size_t)(b*NHEAD+h)*SEQ+e0); v0=src[0];v1=src[1];v2=src[2];v3=src[3]; }
    v0[1]+=v0[0];v0[2]+=v0[1];v0[3]+=v0[2]; v1[0]+=v0[3];v1[1]+=v1[0];v1[2]+=v1[1];v1[3]+=v1[2]; v2[0]+=v1[3];v2[1]+=v2[0];v2[2]+=v2[1];v2[3]+=v2[2]; v3[0]+=v2[3];v3[1]+=v3[0];v3[2]+=v3[1];v3[3]+=v3[2];
    const float tot=v3[3]; float x=tot;
    #pragma unroll
    for(int o=1;o<64;o<<=1){ const float y=__shfl_up(x,o); if(lane>=o)x+=y; }
    if(lane==63)wsf[0]=x;
    asm volatile("s_waitcnt vmcnt(0) lgkmcnt(0)\n\ts_barrier":::"memory");
    float offs=x-tot;
    #pragma unroll
    for(int w=0;w<NW;++w){ const float wt=((const float*)(shm+LDS_WS))[w*64]; if(w<wid)offs+=wt; }
    if(act){ lds_f4p dst=(lds_f4p)(shm+LDS_FB)+tid*4; dst[0]=v0+offs;dst[1]=v1+offs;dst[2]=v2+offs;dst[3]=v3+offs; }
    asm volatile("s_waitcnt vmcnt(0) lgkmcnt(0)\n\ts_barrier":::"memory");
  }
  const lds_f4p fbq=(lds_f4p)(shm+LDS_FB)+hi;
  #define LDBIAS(C0,C1,t) do{ const lds_f4p fp_=fbq+16*(t); const f32x4v a0_=fp_[0],a1_=fp_[2],a2_=fp_[4],a3_=fp_[6],b0_=fp_[8],b1_=fp_[10],b2_=fp_[12],b3_=fp_[14]; \
    _Pragma("unroll") for(int r_=0;r_<4;++r_){ C0[r_]=a0_[r_]-mhat;C0[4+r_]=a1_[r_]-mhat;C0[8+r_]=a2_[r_]-mhat;C0[12+r_]=a3_[r_]-mhat; C1[r_]=b0_[r_]-mhat;C1[4+r_]=b1_[r_]-mhat;C1[8+r_]=b2_[r_]-mhat;C1[12+r_]=b3_[r_]-mhat; } }while(0)
  #define LDB_LOAD(C0,C1,t) do{ const lds_f4p fp_=fbq+16*(t); const f32x4v a0_=fp_[0],a1_=fp_[2],a2_=fp_[4],a3_=fp_[6],b0_=fp_[8],b1_=fp_[10],b2_=fp_[12],b3_=fp_[14]; \
    _Pragma("unroll") for(int r_=0;r_<4;++r_){ C0[r_]=a0_[r_];C0[4+r_]=a1_[r_];C0[8+r_]=a2_[r_];C0[12+r_]=a3_[r_]; C1[r_]=b0_[r_];C1[4+r_]=b1_[r_];C1[8+r_]=b2_[r_];C1[12+r_]=b3_[r_]; } }while(0)
  #define LDB_SUB(C0,C1) do{ _Pragma("unroll") for(int r_=0;r_<16;++r_){ C0[r_]-=mhat; C1[r_]-=mhat; } }while(0)
  DMA_K(0,0);DMA_V(0,0);DMA_K(1,SLOTB);
  bf16x8 qr[4];
  #pragma unroll
  for(int d0=0;d0<4;++d0)qr[d0]=*reinterpret_cast<const bf16x8*>(&Qw[(long)r32*DM+d0*16+hi*8]);
  float mhat=0.f,l_reg=0.f;f32x16 o[2];o[0]=f32x16{};o[1]=f32x16{};
  const int qrel=wid*QBLK+r32;
  #define CMASK(P0,P1,t) do{int jb_=(t)-(NT-4); if(jb_>=0)cmask(P0,P1,jb_,qrel,hi);}while(0)
  bool resc=false;
  #define START(P0,P1) do{ const float rm=rowmax(P0,P1); resc=false; \
    { const float dl=rm; mhat=fadd_s(mhat,dl); \
      _Pragma("unroll") for(int r=0;r<16;++r){P0[r]=fsub_s(P0[r],dl);P1[r]=fsub_s(P1[r],dl);} \
      } \
    _Pragma("unroll") for(int r=0;r<16;++r)P0[r]=__builtin_amdgcn_exp2f(P0[r]); }while(0)
  #define RESC() do{ if(resc){ asm volatile("s_waitcnt lgkmcnt(0)":::"memory"); \
      _Pragma("unroll") for(int d_=0;d_<2;++d_) _Pragma("unroll") for(int r=0;r<16;++r)o[d_][r]*=wsf[crow(r,hi)]; } }while(0)
  f32x16 pA0,pA1,pB0,pB1;
  int sl_prev=0,sl_cur=0,sl_next=SLOTB;
  #define ROT() do{sl_prev=sl_cur;sl_cur=sl_next;sl_next=(sl_next==(NSLOT-1)*SLOTB)?0:sl_next+SLOTB;}while(0)
  DMA_K(2,2*SLOTB);
  WAIT_BAR(3);
  { f32x16 cA0,cA1; LDBIAS(cA0,cA1,0); qkt(pA0,pA1,Kbase,qr,cA0,cA1,r32,hi); } asm volatile("s_nop 15\n\ts_nop 7":"+v"(pA0),"+v"(pA1));CMASK(pA0,pA1,0);
  START(pA0,pA1);
  _Pragma("unroll") for(int r=0;r<16;++r)pA1[r]=__builtin_amdgcn_exp2f(pA1[r]);
  WAIT_BAR(0);
  DMA_K(3,0);DMA_V(1,SLOTB);
  ROT();
  kload8(kf,kp0+sl_cur);
  LDB_LOAD(pB0,pB1,1);
  WAIT_BAR(2);
  s16x4 vlo[8],vhi[8]; u32x4 pw0,pw1,pw2,pw3;
  #define PKW(P,B) cvtpk_s(P[B],P[B+1])
  #define PAF(k) __builtin_bit_cast(bf16x8,pw##k)
  #define VFR(i) (bf16x8){vlo[i][0],vlo[i][1],vlo[i][2],vlo[i][3],vhi[i][0],vhi[i][1],vhi[i][2],vhi[i][3]}
  #define PIN(x) asm volatile("":"+v"(x))
  #define MX3(a,b,c) __builtin_fmaxf(__builtin_fmaxf((a),(b)),(c))
  #define GAPA(MF,A0,A1,A2,A3,W0,W1,PW,CX) do{ MF; sacc+=A0; sacc+=A1; sacc+=A2; sacc+=A3; PIN(sacc); W0; W1; PIN(PW); asm volatile(""::"v"(CX)); SBAR(); }while(0)
  #define EX(v) __builtin_amdgcn_exp2f(v)
  #define GAPB(MF,X,B) do{ MF; X[B]=EX(X[B]); X[B+1]=EX(X[B+1]); X[B+2]=EX(X[B+2]); X[B+3]=EX(X[B+3]); PIN(X); SBAR(); }while(0)
  #define VRD(i) do{ vlo[i]=vtr(vp_+(((i)>>2)*4096+((i)&3)*1024)); vhi[i]=vtr(vp_+(((i)>>2)*4096+((i)&3)*1024+512)); }while(0)
  #define KRD(G,j) do{ if(G){ kload2(kf,kp0+sl_next,j); SBAR(); } }while(0)
  #define STEP(C0,C1,P0,P1,t,GK,GV,GL) do{ SBAR(); \
    LDB_SUB(C0,C1); asm volatile("":"+v"(C0),"+v"(C1)); SBAR(); \
    const lds_cptr vp_=vp0+sl_prev; \
    VRD(0); SBAR(); float sacc=(P0[0]+P0[1]); \
    GAPA(C0=__builtin_amdgcn_mfma_f32_32x32x16_bf16(kf[0],qr[0],C0,0,0,0), P0[2],P0[3],P0[4],P0[5],     pw0[0]=PKW(P0,0), pw0[1]=PKW(P0,2), pw0,C0); \
    VRD(4); SBAR(); GAPA(C1=__builtin_amdgcn_mfma_f32_32x32x16_bf16(kf[1],qr[0],C1,0,0,0), P0[6],P0[7],P0[8],P0[9],     pw0[2]=PKW(P0,4), pw0[3]=PKW(P0,6), pw0,C1); \
    VRD(1); SBAR(); GAPA(C0=__builtin_amdgcn_mfma_f32_32x32x16_bf16(kf[2],qr[1],C0,0,0,0),   P0[10],P0[11],P0[12],P0[13], pw1[0]=PKW(P0,8), pw1[1]=PKW(P0,10), pw1,C0); \
    VRD(5); SBAR(); GAPA(C1=__builtin_amdgcn_mfma_f32_32x32x16_bf16(kf[3],qr[1],C1,0,0,0),   P0[14],P0[15],P1[0],P1[1],   pw1[2]=PKW(P0,12),pw1[3]=PKW(P0,14), pw1,C1); \
    VRD(2); SBAR(); GAPA(C0=__builtin_amdgcn_mfma_f32_32x32x16_bf16(kf[4],qr[2],C0,0,0,0),   P1[2],P1[3],P1[4],P1[5],     pw2[0]=PKW(P1,0), pw2[1]=PKW(P1,2), pw2,C0); \
    VRD(6); SBAR(); GAPA(C1=__builtin_amdgcn_mfma_f32_32x32x16_bf16(kf[5],qr[2],C1,0,0,0),   P1[6],P1[7],P1[8],P1[9],     pw2[2]=PKW(P1,4), pw2[3]=PKW(P1,6), pw2,C1); \
    VRD(3); SBAR(); GAPA(C0=__builtin_amdgcn_mfma_f32_32x32x16_bf16(kf[6],qr[3],C0,0,0,0),   P1[10],P1[11],P1[12],P1[13], pw3[0]=PKW(P1,8), pw3[1]=PKW(P1,10), pw3,C0); \
    VRD(7); SBAR(); GAPA(C1=__builtin_amdgcn_mfma_f32_32x32x16_bf16(kf[7],qr[3],C1,0,0,0),   P1[14],P1[15],0.f,0.f,       pw3[2]=PKW(P1,12),pw3[3]=PKW(P1,14), pw3,C1); \
    l_reg+=sacc; \
    LDB_LOAD(P0,P1,(t)+1); \
    if(GK){DMA_K((t)+3,sl_cur);} if(GV){DMA_V((t)+1,sl_next);} \
    CMASK(C0,C1,t); \
    { float a=MX3(C0[0],C0[1],C1[0]),b=MX3(C0[2],C0[3],C1[1]); a=MX3(a,C1[2],C1[3]); \
      _Pragma("unroll") for(int r=4;r<16;r+=4){a=MX3(a,C0[r],C0[r+1]);b=MX3(b,C0[r+2],C0[r+3]);a=MX3(a,C1[r],C1[r+1]);b=MX3(b,C1[r+2],C1[r+3]);} \
      float rm=__builtin_fmaxf(a,b); { auto rr=__builtin_amdgcn_permlane32_swap(__float_as_uint(rm),__float_as_uint(rm),false,false); rm=__builtin_fmaxf(__uint_as_float(rr[0]),__uint_as_float(rr[1])); } \
      resc=false; \
      if(__builtin_expect(__any(rm>(float)THRL),0)){ const float dl=__builtin_fmaxf(rm,0.f); mhat+=dl; \
        _Pragma("unroll") for(int r=0;r<16;++r){C0[r]-=dl;C1[r]-=dl;} \
        const float f=__builtin_amdgcn_exp2f(-dl); l_reg*=f; if(hi==0)wsf[r32]=f; resc=true; } } \
    SBAR(); \
    GAPB(o[0]=__builtin_amdgcn_mfma_f32_32x32x16_bf16(PAF(0),VFR(0),o[0],0,0,0), C0,0); \
    GAPB(o[1]=__builtin_amdgcn_mfma_f32_32x32x16_bf16(PAF(0),VFR(4),o[1],0,0,0), C0,4); \
    KRD(GL,0); GAPB(o[0]=__builtin_amdgcn_mfma_f32_32x32x16_bf16(PAF(1),VFR(1),o[0],0,0,0), C0,8); \
    KRD(GL,1); GAPB(o[1]=__builtin_amdgcn_mfma_f32_32x32x16_bf16(PAF(1),VFR(5),o[1],0,0,0), C0,12); \
    KRD(GL,2); GAPB(o[0]=__builtin_amdgcn_mfma_f32_32x32x16_bf16(PAF(2),VFR(2),o[0],0,0,0), C1,0); \
    KRD(GL,3); GAPB(o[1]=__builtin_amdgcn_mfma_f32_32x32x16_bf16(PAF(2),VFR(6),o[1],0,0,0), C1,4); \
    GAPB(o[0]=__builtin_amdgcn_mfma_f32_32x32x16_bf16(PAF(3),VFR(3),o[0],0,0,0), C1,8); \
    GAPB(o[1]=__builtin_amdgcn_mfma_f32_32x32x16_bf16(PAF(3),VFR(7),o[1],0,0,0), C1,12); \
    }while(0)
  int t=1;
  #undef CMASK
  #define CMASK(P0,P1,t) do{}while(0)
  for(;t+5<NT;t+=2){
    STEP(pB0,pB1,pA0,pA1,t,true,true,true);     WAIT_BAR(2); RESC(); ROT();
    STEP(pA0,pA1,pB0,pB1,t+1,true,true,true);   WAIT_BAR(2); RESC(); ROT();
  }
  #undef CMASK
  #define CMASK(P0,P1,t) do{int jb_=(t)-(NT-4); if(jb_>=0)cmask(P0,P1,jb_,qrel,hi);}while(0)
  #define ENDW(tt) do{ if((tt)+3<NT){WAIT_BAR(2);} else if((tt)+2<NT){WAIT_BAR(1);} else {WAIT_BAR(0);} }while(0)
  for(;t+1<NT;t+=2){
    STEP(pB0,pB1,pA0,pA1,t,(t+3<NT),(t+1<NT),(t+1<NT));       ENDW(t);   RESC(); ROT();
    STEP(pA0,pA1,pB0,pB1,t+1,(t+4<NT),(t+2<NT),(t+2<NT));     ENDW(t+1); RESC(); ROT();
  }
  STEP(pB0,pB1,pA0,pA1,NT-1,false,false,false); RESC();
  { float sacc=pB0[0]+pB0[1]; _Pragma("unroll") for(int r=2;r<16;++r)sacc+=pB0[r]; _Pragma("unroll") for(int r=0;r<16;++r)sacc+=pB1[r]; l_reg+=sacc;
    pw0=(u32x4){PKW(pB0,0),PKW(pB0,2),PKW(pB0,4),PKW(pB0,6)};pw1=(u32x4){PKW(pB0,8),PKW(pB0,10),PKW(pB0,12),PKW(pB0,14)};pw2=(u32x4){PKW(pB1,0),PKW(pB1,2),PKW(pB1,4),PKW(pB1,6)};pw3=(u32x4){PKW(pB1,8),PKW(pB1,10),PKW(pB1,12),PKW(pB1,14)};
    SBAR(); pv(o,vb0+sl_cur,PAF(0),PAF(1),PAF(2),PAF(3)); }
  #undef PKW
  #undef PAF
  #undef VFR
  #undef PIN
  #undef MX3
  #undef GAPA
  #undef GAPB
  #undef EX
  #undef VRD
  #undef KRD
  #undef STEP
  #undef ENDW
  {auto rr=__builtin_amdgcn_permlane32_swap(__float_as_uint(l_reg),__float_as_uint(l_reg),false,false);l_reg=__uint_as_float(rr[0])+__uint_as_float(rr[1]);}
  if(hi==0)wsf[32+r32]=l_reg;asm volatile("s_waitcnt lgkmcnt(0)":::"memory");
  float rli[16];
  #pragma unroll
  for(int r=0;r<16;++r)rli[r]=__builtin_amdgcn_rcpf(wsf[32+crow(r,hi)]);
  bf16*Ow=O+(rowbase+q0+wid*QBLK)*DM+h*D;
  { bf16*stg=(bf16*)(shm+LDS_OST)+wid*2048;
    #pragma unroll
    for(int r=0;r<16;++r){const int orow=crow(r,hi);
      #pragma unroll
      for(int d0=0;d0<2;++d0)stg[orow*64+d0*32+r32]=__float2bfloat16(o[d0][r]*rli[r]);}
    asm volatile("s_waitcnt lgkmcnt(0)":::"memory");
    #pragma unroll
    for(int i=0;i<4;++i){const int row=i*8+(lane>>3),ch=lane&7; const u32x4 v=*(const u32x4*)(stg+row*64+ch*8); ATTN_STORE16(Ow+(long)row*DM+ch*8,v);} }
  asm volatile("s_waitcnt lgkmcnt(0)\n\ts_barrier":::"memory");
  #undef DMA_K
  #undef DMA_V
  #undef LDBIAS
  #undef LDB_LOAD
  #undef LDB_SUB
  #undef CMASK
  #undef START
  #undef RESC
  #undef ROT
}
constexpr int ATTN_LDS_BYTES=LDS_BYTES;
struct AttnTensors { const bf16* Q; const bf16* K; const bf16* V; bf16* O; const float* NLF; };
struct AttnUnit { int bh; int qb; };
struct StaticOrder {
  int vcu;
  __device__ __forceinline__ explicit StaticOrder(int grid,int block):vcu((block%8)*(grid/8)+block/8){}
  __device__ __forceinline__ bool next(int i,AttnUnit&u)const{ if(i>=4)return false; const int s=vcu&7; u.bh=vcu>>3; u.qb=(i==0)?s:(i==1)?15-s:(i==2)?16+s:31-s; return true; }
  __device__ __forceinline__ void a_ready(const AttnUnit&)const{}
  __device__ __forceinline__ void done(const AttnUnit&)const{}
};
template<class Sched,int THRL=8> __device__ __forceinline__ void attn_phase(char*lds,const AttnTensors&T,const Sched&S){
  AttnUnit u; int prev_bh=-1;
  for(int i=0;S.next(i,u);++i){ S.a_ready(u); attn_unit<THRL>(u.bh/NHEAD,u.bh%NHEAD,u.qb,T.Q,T.K,T.V,T.O,T.NLF,lds,(i==0)||(u.bh!=prev_bh)); prev_bh=u.bh; S.done(u); }
}
#undef SBAR
#undef WAIT_BAR
}
namespace cg = cooperative_groups;
#define GAS __attribute__((address_space(1)))
#define LAS __attribute__((address_space(3)))
typedef unsigned short bf16;
typedef unsigned v4u __attribute__((ext_vector_type(4)));
typedef unsigned v2u __attribute__((ext_vector_type(2)));
typedef float f32x4 __attribute__((ext_vector_type(4)));
typedef float f32x16 __attribute__((ext_vector_type(16)));
typedef short bf16x8 __attribute__((ext_vector_type(8)));
#define LDS_WAIT() asm volatile("s_waitcnt lgkmcnt(0)" ::: "memory")
__device__ __forceinline__ unsigned f2bf(float f) { unsigned u = __builtin_bit_cast(unsigned, f); return (u + 0x7fffu + ((u >> 16) & 1u)) >> 16; }
__device__ __forceinline__ unsigned pk2(float lo, float hi) { return f2bf(lo) | (f2bf(hi) << 16); }
__device__ __forceinline__ float bflo(unsigned w) { return __uint_as_float(w << 16); }
__device__ __forceinline__ float bfhi(unsigned w) { return __uint_as_float(w & 0xffff0000u); }

constexpr int NWAVES = 8;
constexpr int BATCH = 2, SEQ = 8192, D = 1024, M = BATCH * SEQ;
constexpr int FF = 2816, FF2 = 2 * FF;
constexpr int NQKV = 3328, NQKV_SRC = 3088;
constexpr int S5_LC = 256, S5_NCH = SEQ / S5_LC;
constexpr float RMS_EPS = 1e-6f;
constexpr int MODS = 3 * D;

constexpr size_t MiB = 1u << 20;
constexpr int MOD0_FLAG = 3584;
constexpr size_t WS_BAR = 0, WS_PCNT = 16384, BAR_BYTES = 32768;
constexpr size_t WS_XBUF = 512 * 1024;
constexpr size_t WS_MOD = 1 * MiB;
constexpr size_t WS_LAM = WS_MOD + 128 * 1024;
constexpr size_t WS_BF  = WS_LAM + 128 * 1024;
constexpr size_t WS_CF  = WS_BF + 256 * 1024;
constexpr size_t WS_RS = 2 * MiB;
constexpr size_t WS_SW = 2 * MiB + 256 * 1024;
constexpr size_t WS_W1 = 64 * MiB + 110 * MiB;
constexpr size_t WS_NLF = 3 * MiB;
constexpr size_t WS_SC  = 4 * MiB;
constexpr size_t WS_WUP = 6 * MiB, WS_WDN = 17 * MiB, WS_WC = 23 * MiB, WS_WA = 25 * MiB, WS_WB = 27 * MiB, WS_WQKV = 25 * MiB;
constexpr size_t WS_XN = 32 * MiB;
constexpr size_t WS_BIG = 64 * MiB;
constexpr size_t WS_END = 240 * MiB;
static_assert(WS_CF + 512 * 1024 <= WS_NLF && WS_WQKV + (size_t)NQKV * D * 2 <= WS_XN && WS_WDN + (size_t)D * FF * 2 <= WS_WC && WS_WUP + (size_t)FF2 * D * 2 <= WS_WDN, "ws map");
static_assert(WS_BIG + (size_t)M * FF2 * 2 <= WS_END, "ws map");

constexpr int RING_BYTES = 131072, LDS_BYTES = 147456;
static_assert(attn_body::ATTN_LDS_BYTES <= RING_BYTES, "attention LDS");

__device__ __forceinline__ float wave_sum(float v) {
#pragma unroll
    for (int o = 1; o < 64; o <<= 1) v += __shfl_xor(v, o);
    return v;
}
__device__ __forceinline__ void transpose_item(const float* W, int ldw, int nblk, int K, bf16* WT, int row_off, LAS float* scr, int item, int lane, int ilv = 0) {
    const int kb = item / nblk, nb = item % nblk, k0 = 64 * kb, n0 = 32 * nb;
    const int n0d = (ilv == 0) ? n0 : (n0 < ilv ? 256 * (n0 >> 7) + (n0 & 127) : 256 * ((n0 - ilv) >> 7) + 128 + ((n0 - ilv) & 127));
#pragma unroll 8
    for (int i = 0; i < 32; ++i) { const int kk = 2 * i + (lane >> 5); scr[kk * 33 + (lane & 31)] = W[(size_t)(k0 + kk) * ldw + n0 + (lane & 31)]; }
    LDS_WAIT(); asm volatile("" ::: "memory");
    const int c = lane & 7;
#pragma unroll
    for (int j = 0; j < 4; ++j) { const int n = (lane >> 3) + 8 * j; const LAS float* s = scr + (8 * c) * 33 + n;
        v4u o; o.x = pk2(s[0 * 33], s[1 * 33]); o.y = pk2(s[2 * 33], s[3 * 33]); o.z = pk2(s[4 * 33], s[5 * 33]); o.w = pk2(s[6 * 33], s[7 * 33]);
        *(GAS v4u*)(WT + (size_t)(row_off + n0d + n) * K + k0 + 8 * c) = o; }
    LDS_WAIT(); asm volatile("" ::: "memory");
}
__device__ __forceinline__ void norm_mod_phase(const float* X, bf16* XN, const float* g, const float* mod  , int gw, int NGW, int lane) {
    for (int b = 0; b < BATCH; ++b) {
        f32x4 gs[4], sh[4];
#pragma unroll
        for (int j = 0; j < 4; ++j) { const f32x4 gg = ((const f32x4*)g)[lane + 64 * j]; const f32x4 sc = ((const f32x4*)(mod + b * MODS + D))[lane + 64 * j];
            gs[j] = gg * (sc + 1.0f); sh[j] = ((const f32x4*)(mod + b * MODS))[lane + 64 * j]; }
        for (int t = gw; t < SEQ; t += NGW) { const size_t row = (size_t)b * SEQ + t;
            const f32x4* xr = (const f32x4*)(X + row * D) + lane; f32x4 v[4]; float s = 0.f;
#pragma unroll
            for (int j = 0; j < 4; ++j) { v[j] = xr[64 * j]; s += (v[j].x * v[j].x + v[j].y * v[j].y) + (v[j].z * v[j].z + v[j].w * v[j].w); }
            const float rstd = 1.0f / sqrtf(wave_sum(s) * (1.0f / D) + RMS_EPS);
            v2u* o8 = (v2u*)(XN + row * D) + lane;
#pragma unroll
            for (int j = 0; j < 4; ++j) { const f32x4 y = v[j] * rstd * gs[j] + sh[j]; v2u w; w.x = pk2(y.x, y.y); w.y = pk2(y.z, y.w); o8[64 * j] = w; }
        }
    }
}
__device__ __forceinline__ void final_norm_phase(float* X, const float* g, int gw, int NGW, int lane) {
    f32x4 gs[4];
#pragma unroll
    for (int j = 0; j < 4; ++j) gs[j] = ((const f32x4*)g)[lane + 64 * j];
    for (int row = gw; row < M; row += NGW) {
        f32x4* xr = (f32x4*)(X + (size_t)row * D) + lane; f32x4 v[4]; float s = 0.f;
#pragma unroll
        for (int j = 0; j < 4; ++j) { v[j] = xr[64 * j]; s += (v[j].x * v[j].x + v[j].y * v[j].y) + (v[j].z * v[j].z + v[j].w * v[j].w); }
        const float rstd = 1.0f / sqrtf(wave_sum(s) * (1.0f / D) + RMS_EPS);
#pragma unroll
        for (int j = 0; j < 4; ++j) xr[64 * j] = v[j] * rstd * gs[j];
    }
}
__device__ __forceinline__ void conv_phase(bf16* AB, const float* cw, const float* cb, int gw, int NGW, int lane) {
    constexpr int RB = 16, NRB = M / RB, NCB = 6, NCH = FF / 8;
    for (int it = gw; it < NRB * NCB; it += NGW) {
        const int cbk = it % NCB, rb = it / NCB, ch = cbk * 64 + lane; if (ch >= NCH) continue;
        const int f0 = ch * 8, r0 = rb * RB, t0 = r0 & (SEQ - 1);
        const f32x4 w0a = *(const f32x4*)(cw + f0), w0b = *(const f32x4*)(cw + f0 + 4), w1a = *(const f32x4*)(cw + FF + f0), w1b = *(const f32x4*)(cw + FF + f0 + 4),
                    w2a = *(const f32x4*)(cw + 2 * FF + f0), w2b = *(const f32x4*)(cw + 2 * FF + f0 + 4), cba = *(const f32x4*)(cb + f0), cbb = *(const f32x4*)(cb + f0 + 4);
        f32x4 p2a = {0.f, 0.f, 0.f, 0.f}, p2b = p2a, p1a = p2a, p1b = p2a;
        bf16* base = AB + (size_t)r0 * FF2 + f0;
        if (t0 != 0) { const v4u q2 = *(const v4u*)(base - 2 * (size_t)FF2), q1 = *(const v4u*)(base - (size_t)FF2);
            p2a = (f32x4){bflo(q2.x), bfhi(q2.x), bflo(q2.y), bfhi(q2.y)}; p2b = (f32x4){bflo(q2.z), bfhi(q2.z), bflo(q2.w), bfhi(q2.w)};
            p1a = (f32x4){bflo(q1.x), bfhi(q1.x), bflo(q1.y), bfhi(q1.y)}; p1b = (f32x4){bflo(q1.z), bfhi(q1.z), bflo(q1.w), bfhi(q1.w)}; }
#pragma unroll 4
        for (int i = 0; i < RB; ++i) { bf16* rp = base + (size_t)i * FF2;
            const v4u qa = *(const v4u*)rp, qb = *(const v4u*)(rp + FF);
            const f32x4 aa = {bflo(qa.x), bfhi(qa.x), bflo(qa.y), bfhi(qa.y)}, ab = {bflo(qa.z), bfhi(qa.z), bflo(qa.w), bfhi(qa.w)};
            const f32x4 ba = {bflo(qb.x), bfhi(qb.x), bflo(qb.y), bfhi(qb.y)}, bb = {bflo(qb.z), bfhi(qb.z), bflo(qb.w), bfhi(qb.w)};
            const f32x4 ca = cba + w0a * p2a + w1a * p1a + w2a * aa, cc = cbb + w0b * p2b + w1b * p1b + w2b * ab;
            f32x4 ga, gb;
#pragma unroll
            for (int e = 0; e < 4; ++e) { ga[e] = ca[e] * __builtin_amdgcn_rcpf(1.0f + __expf(-ca[e])) * ba[e]; gb[e] = cc[e] * __builtin_amdgcn_rcpf(1.0f + __expf(-cc[e])) * bb[e]; }
            v4u o; o.x = pk2(ga[0], ga[1]); o.y = pk2(ga[2], ga[3]); o.z = pk2(gb[0], gb[1]); o.w = pk2(gb[2], gb[3]);
            *(v4u*)(rp + FF) = o;
            p2a = p1a; p2b = p1b; p1a = aa; p1b = ab; }
    }
}
__device__ __forceinline__ void ffn_fixup(bf16* Gm, const float* fixa, const float* fixb, const float* halo, const float* cw, const float* cb, int pm, int tid) {
    constexpr int F4 = FF / 4;
    for (int it = tid; it < 8 * F4; it += NWAVES * 64) { const int f = (it % F4) * 4, rj = it / F4, sp = pm * 4 + (rj >> 1), j = rj & 1; const bool first = (sp & 127) == 0;
        const f32x4 z = {0.f, 0.f, 0.f, 0.f};
        const f32x4 a0 = *(const f32x4*)(fixa + (size_t)(sp * 2 + j) * FF + f), b0 = *(const f32x4*)(fixb + (size_t)(sp * 2 + j) * FF + f);
        const f32x4 h1 = first ? z : *(const f32x4*)(halo + (size_t)(sp * 2 - 1) * FF + f);
        const f32x4 h0 = first ? z : *(const f32x4*)(halo + (size_t)(sp * 2 - 2) * FF + f);
        const f32x4 am1 = (j == 0) ? h1 : *(const f32x4*)(fixa + (size_t)(sp * 2) * FF + f), am2 = (j == 0) ? h0 : h1;
        const f32x4 w0 = *(const f32x4*)(cw + f), w1 = *(const f32x4*)(cw + FF + f), w2 = *(const f32x4*)(cw + 2 * FF + f), wb = *(const f32x4*)(cb + f);
        const f32x4 c = wb + w0 * am2 + w1 * am1 + w2 * a0; f32x4 g;
#pragma unroll
        for (int e = 0; e < 4; ++e) g[e] = c[e] * __builtin_amdgcn_rcpf(1.0f + __expf(-c[e])) * b0[e];
        v2u w; w.x = pk2(g[0], g[1]); w.y = pk2(g[2], g[3]); *(v2u*)(Gm + (size_t)(sp * 64 + j) * FF + f) = w; }
}
__device__ __forceinline__ void s5_precompute(int g, int lane, const float* lam_re, const float* lam_im, const float* log_dt, const float* b_re, const float* b_im, const float* c_re, const float* c_im,
                                              float* LAM, bf16x8* BF, bf16x8* CF) {
    const int p0 = lane & 31, kh = lane >> 5; const float dt = expf(log_dt[g]);
    float lamv[8];
#pragma unroll
    for (int st = 0; st < 2; ++st) { const int p = p0 + 32 * st; const float lre = lam_re[g * 64 + p], lim = lam_im[g * 64 + p];
        const float mag = expf(lre * dt), ang = lim * dt; const float lbr = mag * cosf(ang), lbi = mag * sinf(ang);
        const float num_re = lbr - 1.0f, den = lre * lre + lim * lim; const float k_re = (num_re * lre + lbi * lim) / den, k_im = (lbi * lre - num_re * lim) / den;
        float Lr = lbr, Li = lbi;
#pragma unroll
        for (int s = 0; s < 8; ++s) { const float nr = Lr * Lr - Li * Li, ni = 2.0f * Lr * Li; Lr = nr; Li = ni; }
        lamv[2 * st] = lbr; lamv[2 * st + 1] = lbi; lamv[4 + 2 * st] = Lr; lamv[5 + 2 * st] = Li;
        const float* br = b_re + (size_t)(g * 64 + p) * 16 + 8 * kh; const float* bi = b_im + (size_t)(g * 64 + p) * 16 + 8 * kh;
        float re[8], im[8];
#pragma unroll
        for (int e = 0; e < 8; ++e) { re[e] = k_re * br[e] - k_im * bi[e]; im[e] = k_re * bi[e] + k_im * br[e]; }
        v4u wr, wi; wr.x = pk2(re[0], re[1]); wr.y = pk2(re[2], re[3]); wr.z = pk2(re[4], re[5]); wr.w = pk2(re[6], re[7]);
        wi.x = pk2(im[0], im[1]); wi.y = pk2(im[2], im[3]); wi.z = pk2(im[4], im[5]); wi.w = pk2(im[6], im[7]);
        ((v4u*)BF)[(g * 4 + st) * 64 + lane] = wr; ((v4u*)BF)[(g * 4 + 2 + st) * 64 + lane] = wi; }
    ((f32x4*)LAM)[(g * 64 + lane) * 2] = (f32x4){lamv[0], lamv[1], lamv[2], lamv[3]}; ((f32x4*)LAM)[(g * 64 + lane) * 2 + 1] = (f32x4){lamv[4], lamv[5], lamv[6], lamv[7]};
    const int c = lane & 31;
#pragma unroll
    for (int ks = 0; ks < 8; ++ks) { float v[8];
#pragma unroll
        for (int e = 0; e < 8; ++e) { const int kp = 16 * ks + 8 * kh + e, p = kp >> 2, j = kp & 3; float x = 0.f;
            if (c < 16) { const size_t idx = (size_t)(g * 16 + c) * 64 + p + ((j & 1) ? 32 : 0); x = (j < 2) ? c_re[idx] : -c_im[idx]; }
            v[e] = x; }
        v4u w; w.x = pk2(v[0], v[1]); w.y = pk2(v[2], v[3]); w.z = pk2(v[4], v[5]); w.w = pk2(v[6], v[7]);
        ((v4u*)CF)[(g * 8 + ks) * 64 + lane] = w; }
}
__device__ __forceinline__ float gelu_tanh(float v) { const float z = 1.5957691216057308f * (v + 0.044715f * v * v * v); return v * __builtin_amdgcn_rcpf(1.0f + __expf(-z)); }
template <bool OUT> __device__ __forceinline__ void s5_scan(LAS unsigned char* lds, const bf16* U, bf16* Y, float* SC, const float* LAM, const bf16x8* BF, const bf16x8* CF, const float* dskip, int bid, int G, int wave, int lane) {
    for (int unit = bid; unit < S5_NCH * 8; unit += G) {
        const int c = unit >> 3, g = (unit & 7) * 8 + wave;
        const int hb = lane >> 5, p0 = lane & 31;
        const f32x4 la = ((const f32x4*)LAM)[(g * 64 + lane) * 2];
        const float lr0 = la.x, li0 = la.y, lr1 = la.z, li1 = la.w;
        const bf16x8 bf0 = BF[(g * 4 + 0) * 64 + lane], bf1 = BF[(g * 4 + 1) * 64 + lane], bf2 = BF[(g * 4 + 2) * 64 + lane], bf3 = BF[(g * 4 + 3) * 64 + lane];
        float hr0 = 0.f, hi0 = 0.f, hr1 = 0.f, hi1 = 0.f;
        if (OUT) { const f32x4 Lb = ((const f32x4*)LAM)[(g * 64 + lane) * 2 + 1];
            for (int j0 = 0; j0 < c; j0 += 8) { f32x4 sv[8];
#pragma unroll
                for (int q = 0; q < 8; ++q) sv[q] = (j0 + q < c) ? ((const f32x4*)SC)[((size_t)(j0 + q) * 64 + g) * 64 + lane] : (f32x4){0.f, 0.f, 0.f, 0.f};
#pragma unroll
                for (int q = 0; q < 8; ++q) if (j0 + q < c) { const f32x4 s = sv[q];
                    const float nr0 = Lb.x * hr0 - Lb.y * hi0 + s.x, ni0 = Lb.x * hi0 + Lb.y * hr0 + s.y, nr1 = Lb.z * hr1 - Lb.w * hi1 + s.z, ni1 = Lb.z * hi1 + Lb.w * hr1 + s.w;
                    hr0 = nr0; hi0 = ni0; hr1 = nr1; hi1 = ni1; } } }
        const int m = lane & 31, bA = (m >> 2) & 1, jA = (m & 3) + 4 * (m >> 3), kh = lane >> 5;
        const bf16* up = U + ((size_t)bA * SEQ + (size_t)c * S5_LC + jA) * D + g * 16 + kh * 8;
        LAS unsigned char* hbuf = lds + wave * 8704;
        bf16x8 cf[8], dfrag = {0, 0, 0, 0, 0, 0, 0, 0};
        if (OUT) {
#pragma unroll
            for (int ks = 0; ks < 8; ++ks) cf[ks] = CF[(g * 8 + ks) * 64 + lane];
            if (p0 < 16 && (p0 >> 3) == kh) { const short dv = (short)f2bf(dskip[g * 16 + p0]);
#pragma unroll
                for (int e = 0; e < 8; ++e) if ((p0 & 7) == e) dfrag[e] = dv; } }
        bf16x8 af_n = *(const bf16x8*)up;
        for (int st = 0; st < S5_LC / 16; ++st) {
            const bf16x8 af = af_n; if (st + 1 < S5_LC / 16) af_n = *(const bf16x8*)(up + (size_t)(st + 1) * 16 * D);
            const f32x16 z16 = {0.f, 0.f, 0.f, 0.f, 0.f, 0.f, 0.f, 0.f, 0.f, 0.f, 0.f, 0.f, 0.f, 0.f, 0.f, 0.f};
            f32x16 d0 = __builtin_amdgcn_mfma_f32_32x32x16_bf16(af, bf0, z16, 0, 0, 0), d1 = __builtin_amdgcn_mfma_f32_32x32x16_bf16(af, bf1, z16, 0, 0, 0),
                   d2 = __builtin_amdgcn_mfma_f32_32x32x16_bf16(af, bf2, z16, 0, 0, 0), d3 = __builtin_amdgcn_mfma_f32_32x32x16_bf16(af, bf3, z16, 0, 0, 0);
#pragma unroll
            for (int i = 0; i < 16; ++i) {
                const float nr0 = fmaf(lr0, hr0, fmaf(-li0, hi0, d0[i])), ni0 = fmaf(lr0, hi0, fmaf(li0, hr0, d2[i]));
                const float nr1 = fmaf(lr1, hr1, fmaf(-li1, hi1, d1[i])), ni1 = fmaf(lr1, hi1, fmaf(li1, hr1, d3[i]));
                hr0 = nr0; hi0 = ni0; hr1 = nr1; hi1 = ni1; d0[i] = nr0; d2[i] = ni0; d1[i] = nr1; d3[i] = ni1; }
            if (OUT) {
#pragma unroll
                for (int i = 0; i < 16; ++i) { const int row = (i & 3) + 8 * (i >> 2) + 4 * hb; v2u w; w.x = pg8::cvt_pk_bf16(d0[i], d1[i]); w.y = pg8::cvt_pk_bf16(d2[i], d3[i]);
                    *(LAS v2u*)(hbuf + row * 272 + 8 * p0) = w; }
                f32x16 y = __builtin_amdgcn_mfma_f32_32x32x16_bf16(af, dfrag, z16, 0, 0, 0);
#pragma unroll
                for (int ks = 0; ks < 8; ++ks) { const bf16x8 a2 = *(const LAS bf16x8*)(hbuf + m * 272 + 32 * ks + 16 * kh); y = __builtin_amdgcn_mfma_f32_32x32x16_bf16(a2, cf[ks], y, 0, 0, 0); }
                if (p0 < 16) {
#pragma unroll
                    for (int i = 0; i < 16; ++i) *(LAS float*)(hbuf + ((i & 3) + 8 * (i >> 2) + 4 * hb) * 80 + 4 * p0) = y[i]; }
                { const int slot = lane >> 1, c8 = (lane & 1) * 8, sb = (slot >> 2) & 1, sj = (slot & 3) + 4 * (slot >> 3);
                  const f32x4 y0 = *(const LAS f32x4*)(hbuf + slot * 80 + 4 * c8), y1 = *(const LAS f32x4*)(hbuf + slot * 80 + 4 * c8 + 16);
                  v4u w; w.x = pg8::cvt_pk_bf16(gelu_tanh(y0[0]), gelu_tanh(y0[1])); w.y = pg8::cvt_pk_bf16(gelu_tanh(y0[2]), gelu_tanh(y0[3]));
                  w.z = pg8::cvt_pk_bf16(gelu_tanh(y1[0]), gelu_tanh(y1[1])); w.w = pg8::cvt_pk_bf16(gelu_tanh(y1[2]), gelu_tanh(y1[3]));
                  *(v4u*)(Y + ((size_t)sb * SEQ + (size_t)c * S5_LC + st * 16 + sj) * D + g * 16 + c8) = w; }
            }
        }
        if (!OUT) ((f32x4*)SC)[((size_t)c * 64 + g) * 64 + lane] = (f32x4){hr0, hi0, hr1, hi1};
    }
}
#define XB_TMO      128
#define XB_XCNT(j)  (256  + 64 * (j))
#define XB_XSUB(j)  (1280 + 64 * (j))
#define XB_XGEN(j)  (2304 + 64 * (j))
#define XB_TOP      3328
#define XB_TOPGEN   3392
#define XCD_BAR_WORDS 3456
#define XB_SPIN_CAP (1u << 18)

__device__ __forceinline__ unsigned xb_ld(unsigned* p)              { return __hip_atomic_load(p, __ATOMIC_RELAXED, __HIP_MEMORY_SCOPE_AGENT); }
__device__ __forceinline__ unsigned xb_add(unsigned* p, unsigned v) { return __hip_atomic_fetch_add(p, v, __ATOMIC_RELAXED, __HIP_MEMORY_SCOPE_AGENT); }
__device__ __forceinline__ unsigned xb_xcc_id() { return (unsigned)__builtin_amdgcn_s_getreg((3 << 11) | 20) & 0xFu; }
#define XB_SPIN(cond, bar) do { unsigned _sp = 0; while (cond) { __builtin_amdgcn_s_sleep(1); \
    if ((++_sp & 255u) == 0u) { if (xb_ld(&(bar)[XB_TMO])) break; if (_sp > XB_SPIN_CAP) { atomicAdd(&(bar)[XB_TMO], 1u); break; } } } } while (0)

struct XcdBarrier {
    unsigned* bar; unsigned x;
    volatile LAS unsigned* st;
};

__device__ __forceinline__ XcdBarrier xcd_barrier_post(unsigned* bar, volatile LAS unsigned* st) {
    XcdBarrier b; b.bar = bar; b.x = xb_xcc_id(); b.st = st;
    if (threadIdx.x == 0) (void)xb_add(&bar[XB_XCNT(b.x)], 1u);
    return b;
}
__device__ __forceinline__ void xcd_barrier_complete(unsigned* bar, unsigned x, unsigned& nloc, unsigned& nx) {
    const unsigned G = gridDim.x * gridDim.y * gridDim.z;
    unsigned sum, cnt, mine, sp = 0u;
    for (;;) {
        sum = 0u; cnt = 0u; mine = 0u;
#pragma unroll
        for (unsigned j = 0; j < 16; ++j) { const unsigned c = xb_ld(&bar[XB_XCNT(j)]); sum += c; cnt += (c > 0u) ? 1u : 0u; mine = (j == x) ? c : mine; }
        if (sum == G) break;
        __builtin_amdgcn_s_sleep(1);
        if ((++sp & 255u) == 0u) { if (xb_ld(&bar[XB_TMO])) break; if (sp > XB_SPIN_CAP) { atomicAdd(&bar[XB_TMO], 1u); break; } }
    }
    nloc = mine > 0u ? mine : 1u; nx = cnt > 0u ? cnt : 1u;
}

__device__ __forceinline__ void xcd_barrier(const XcdBarrier& b) {
    asm volatile("s_waitcnt vmcnt(0)" ::: "memory");
    __syncthreads();
    if (threadIdx.x == 0) {
        unsigned* bar = b.bar;
        __builtin_amdgcn_s_waitcnt(0);
        unsigned nloc = b.st[0], nx = b.st[1];
        if (nloc == 0u) { xcd_barrier_complete(bar, b.x, nloc, nx); b.st[0] = nloc; b.st[1] = nx; }
        const unsigned old = xb_add(&bar[XB_XSUB(b.x)], 1u);
        const unsigned gen = old / nloc;
        if (old + 1u == (gen + 1u) * nloc) {
            __builtin_amdgcn_fence(__ATOMIC_RELEASE, "agent");
            asm volatile("s_waitcnt vmcnt(0)" ::: "memory");
            const unsigned og = xb_add(&bar[XB_TOP], 1u);
            const unsigned tg = og / nx;
            if (og + 1u == (tg + 1u) * nx) xb_add(&bar[XB_TOPGEN], 1u);
            else XB_SPIN(xb_ld(&bar[XB_TOPGEN]) == tg, bar);
            __builtin_amdgcn_fence(__ATOMIC_ACQUIRE, "agent");
            xb_add(&bar[XB_XGEN(b.x)], 1u);
            asm volatile("s_waitcnt vmcnt(0)" ::: "memory");
        } else {
            XB_SPIN(xb_ld(&bar[XB_XGEN(b.x)]) == gen, bar);
            __builtin_amdgcn_fence(__ATOMIC_ACQUIRE, "agent");
            asm volatile("s_waitcnt vmcnt(0)" ::: "memory");
        }
    }
    __syncthreads();
}

constexpr int N_PHASES = 15;
#ifndef MK_PER_PHASE
#define MK_PER_PHASE 0
#endif
__device__ __forceinline__ void fgate_rows(const bf16* XNp, const bf16* Wf, const float* rs, const float* swf  , const float* bfg, float* nlf, int gw, int NGW, int lane) {
    const int r16 = lane & 15, kq = lane >> 4;
    for (int it = gw; it < M / 16; it += NGW) {
        const bf16* ap = XNp + (size_t)(it * 16 + r16) * D + kq * 8; const bf16* bp = Wf + (size_t)r16 * D + kq * 8;
        f32x4 acc = {0.f, 0.f, 0.f, 0.f};
#pragma unroll 8
        for (int ks = 0; ks < D / 32; ++ks) { const bf16x8 a = *(const bf16x8*)(ap + ks * 32), b = *(const bf16x8*)(bp + ks * 32); acc = __builtin_amdgcn_mfma_f32_16x16x32_bf16(a, b, acc, 0, 0, 0); }
        const int h = r16; const int bb = (it * 16) >> 13; const float add = swf[(size_t)bb * 3328 + h] + bfg[h];
#pragma unroll
        for (int i = 0; i < 4; ++i) { const int row = it * 16 + 4 * kq + i, t = row & 8191; const float x = acc[i] * pg8::rstd_of(rs + row) + add;
            const float e = __expf(-fabsf(x)); const float sp = fmaxf(-x, 0.0f) + ((e < 1e-3f) ? e * (1.0f - e * (0.5f - e * 0.33333333f)) : __logf(1.0f + e));
            nlf[(size_t)(bb * 16 + h) * 8192 + t] = sp * 1.4426950408889634f; }
    }
}
__device__ __forceinline__ void shiftw_rows(const bf16* WT, int N, const float* shift0, float* SW, int gw, int NGW, int lane) {
    f32x4 s0[4], s1[4];
#pragma unroll
    for (int j = 0; j < 4; ++j) { s0[j] = ((const f32x4*)shift0)[lane * 4 + j]; s1[j] = ((const f32x4*)(shift0 + MODS))[lane * 4 + j]; }
    for (int n = gw; n < N; n += NGW) { const v4u* wp = (const v4u*)(WT + (size_t)n * D) + lane * 2; const v4u q0 = wp[0], q1 = wp[1];
        const f32x4 w0 = {bflo(q0.x), bfhi(q0.x), bflo(q0.y), bfhi(q0.y)}, w1 = {bflo(q0.z), bfhi(q0.z), bflo(q0.w), bfhi(q0.w)}, w2 = {bflo(q1.x), bfhi(q1.x), bflo(q1.y), bfhi(q1.y)}, w3 = {bflo(q1.z), bfhi(q1.z), bflo(q1.w), bfhi(q1.w)};
        const f32x4 p0 = w0 * s0[0] + w1 * s0[1] + w2 * s0[2] + w3 * s0[3], p1 = w0 * s1[0] + w1 * s1[1] + w2 * s1[2] + w3 * s1[3];
        const float r0 = wave_sum((p0[0] + p0[1]) + (p0[2] + p0[3])), r1 = wave_sum((p1[0] + p1[1]) + (p1[2] + p1[3]));
        if (lane == 0) { SW[n] = r0; SW[N + n] = r1; } }
}
struct Args { const float* in[24]; float* out; unsigned char* ws; int ph_lo, ph_hi; };
#define ws (args.ws)
#define x_in (args.in[0])
#define cvec (args.in[1])
#define norm_g (args.in[2])
#define ada_w (args.in[3])
#define ada_b (args.in[4])
#define out (args.out)
#define MOD ((float*)(ws + WS_MOD))
#define MODS_(s) (MOD + (size_t)(s) * 2 * MODS)
#define LAM ((float*)(ws + WS_LAM))
#define BFm ((bf16x8*)(ws + WS_BF))
#define CFm ((bf16x8*)(ws + WS_CF))
#define NLF ((float*)(ws + WS_NLF))
#define SC ((float*)(ws + WS_SC))
#define RS_(k) ((float*)(ws + WS_RS) + (size_t)(k) * M)
#define SW_UP_(L) ((float*)(ws + WS_SW + ((L) == 0 ? 0 : 128 * 1024)))
#define SW_QKV ((float*)(ws + WS_SW + 64 * 1024))
#define W_A ((bf16*)(ws + WS_WA))
#define W_B ((bf16*)(ws + WS_WB))
#define W_C_(L) ((bf16*)(ws + ((L) == 0 ? WS_WC : WS_W1 + 7 * MiB)))
#define W_UP_(L) ((bf16*)(ws + ((L) == 0 ? WS_WUP : WS_W1 + 9 * MiB)))
#define W_DN_(L) ((bf16*)(ws + ((L) == 0 ? WS_WDN : WS_W1 + 20 * MiB)))
#define W_QKV ((bf16*)(ws + WS_W1))
#define XN ((bf16*)(ws + WS_XN))
#define BIG ((bf16*)(ws + WS_BIG))
#define FIXA ((float*)(ws + WS_BIG + 88 * MiB))
#define FIXB ((float*)(ws + WS_BIG + 94 * MiB))
#define HALO ((float*)(ws + WS_BIG + 100 * MiB))
#define HBF ((bf16*)(ws + WS_BIG + 136 * MiB))
#define T0 BIG
#define T1 (BIG + (size_t)M * D)
#define T2 (BIG + 2 * (size_t)M * D)
#define RUN(k) (lo <= (k) && (k) < hi)
#define SEAM(k) do { if (RUN(k) && RUN((k) + 1)) xcd_barrier(bar); } while (0)
#define IDS() const int tid = opaque_tid(), lane = tid & 63, wave = __builtin_amdgcn_readfirstlane(tid >> 6), gw = vcu * NWAVES + wave; (void)gw; (void)lane; LAS float* scr = (LAS float*)(lds + wave * 16384); (void)scr
#define hin ((L == 0) ? x_in : (const float*)out)
template <int L> __device__ __forceinline__ void layer_phases(const Args& args, const XcdBarrier& bar, LAS unsigned char* lds, unsigned char* lds_raw, const int G, const int bid, const int vcu, const int NGW, const int lo, const int hi) {
        const int pf = (L == 0) ? 7 : 12;
        if (L == 0) {
            if (RUN(2)) { pg8::Gemm g{XN, W_A, M, D, D, D}; pg8::StaticOrder S; S.init(M, D, G, bid); pg8::EpiBf16<0> E{T0, D, nullptr, 0, 0, 1.f};
                pg8::gemm_phase<pg8::EpiBf16<0>, pg8::StaticOrder, true, true>(lds, g, S, E); }
            SEAM(2);
            if (RUN(3)) { IDS(); shiftw_rows(W_UP_(0), FF2, MODS_(1), SW_UP_(0), gw, NGW, lane); s5_scan<false>(lds, T0, T1, SC, LAM, BFm, CFm, args.in[13], bid, G, wave, lane); }
            SEAM(3);
            if (RUN(4)) { IDS(); s5_scan<true>(lds, T0, T1, SC, LAM, BFm, CFm, args.in[13], bid, G, wave, lane); }
            SEAM(4);
            if (RUN(5)) { pg8::Gemm g{T1, W_B, M, D, D, D}; pg8::StaticOrder S; S.init(M, D, G, bid); pg8::EpiGlu E{T1, T2, D};
                pg8::gemm_phase<pg8::EpiGlu, pg8::StaticOrder, true, true>(lds, g, S, E); }
            SEAM(5);
            if (RUN(6)) { pg8::Gemm g{T2, W_C_(0), M, D, D, D}; pg8::StaticOrder S; S.init(M, D, G, bid);
                pg8::EpiResNorm<false> E{x_in, HBF, D, MODS_(0) + 2 * D, MODS, norm_g + (size_t)1 * D, MODS_(1) + D, XN, RS_(0)};
                pg8::gemm_phase<pg8::EpiResNorm<false>, pg8::StaticOrder, true, true>(lds, g, S, E); }
            SEAM(6);
        } else {
            if (RUN(9)) { pg8::Gemm g{XN, W_QKV, M, 3072, D, D}; pg8::StaticOrder S; S.init(M, 3072, G, bid);
                pg8::EpiQkvF E{T0, (size_t)M * D, attn_body::C2, args.in[17], NLF, RS_(1), SW_QKV};
                pg8::gemm_phase<pg8::EpiQkvF, pg8::StaticOrder, true, true>(lds, g, S, E);
                { IDS(); fgate_rows(XN, W_QKV + (size_t)3072 * D, RS_(1), SW_QKV + 3072, args.in[17], NLF, gw, NGW, lane); } }
            SEAM(9);
            if (RUN(10)) { const attn_body::AttnTensors AT{(const attn_body::bf16*)T0, (const attn_body::bf16*)T1, (const attn_body::bf16*)T2, (attn_body::bf16*)T0, NLF};
                const attn_body::StaticOrder S(G, bid); attn_body::attn_phase<attn_body::StaticOrder, 96>((char*)lds_raw, AT, S); }
            SEAM(10);
            if (RUN(11)) { pg8::Gemm g{T0, W_C_(1), M, D, D, D}; pg8::StaticOrder S; S.init(M, D, G, bid);
                pg8::EpiResNorm<true> E{HBF, HBF, D, MODS_(2) + 2 * D, MODS, norm_g + (size_t)3 * D, MODS_(3) + D, XN, RS_(2)};
                pg8::gemm_phase<pg8::EpiResNorm<true>, pg8::StaticOrder, true, true>(lds, g, S, E); }
            SEAM(11);
        }
        if (RUN(pf)) { pg8::Gemm g{XN, W_UP_(L), M, FF2, D, D}; pg8::StaticOrder S; S.init(M, FF2, G, bid);
            pg8::EpiConvGate E{BIG, FIXA, FIXB, HALO, args.in[20] + (size_t)L * 3 * FF, args.in[21] + (size_t)L * FF, FF, RS_(L == 0 ? 0 : 2), SW_UP_(L)};
            pg8::gemm_phase<pg8::EpiConvGate, pg8::StaticOrder, true, true>(lds, g, S, E);
            if (L == 0) {
                IDS(); const int rem = S.nwg % G; const bool idle = (rem == 0) || bid >= rem; const int nidle = (rem == 0) ? G : G - rem, gwl = ((rem == 0) ? bid : bid - rem) * NWAVES + wave, NGL = nidle * NWAVES;
                if (idle) {
                    constexpr int I_SQ = (D / 64) * (D / 32), I_UP = (D / 64) * (FF2 / 32), I_DN = (FF / 64) * (D / 32), I_QKV = (D / 64) * (3072 / 32);
                    constexpr int NITEMS = I_SQ + I_UP + 2 * I_DN + I_QKV;
                    for (int it = gwl; it < NITEMS; it += NGL) { int r = it;
                        if (r < I_DN) { transpose_item(args.in[22], D, D / 32, FF, W_DN_(0), 0, scr, r, lane); continue; } r -= I_DN;
                        if (r < I_QKV) { transpose_item(args.in[16], NQKV_SRC, 3072 / 32, D, W_QKV, 0, scr, r, lane); continue; } r -= I_QKV;
                        if (r < I_SQ) { transpose_item(args.in[18], D, D / 32, D, W_C_(1), 0, scr, r, lane); continue; } r -= I_SQ;
                        if (r < I_UP) { transpose_item(args.in[19] + (size_t)D * FF2, FF2, FF2 / 32, D, W_UP_(1), 0, scr, r, lane, FF); continue; } r -= I_UP;
                        transpose_item(args.in[22] + (size_t)FF * D, D, D / 32, FF, W_DN_(1), 0, scr, r, lane); }
                    const float* fox_w_in = args.in[16]; const int gt = gwl * 64 + lane, NGT = NGL * 64;
                    for (int i = gt; i < 16 * D; i += NGT) { const int n = i >> 10, k = i & 1023; W_QKV[(size_t)(3072 + n) * D + k] = (bf16)f2bf(fox_w_in[(size_t)k * NQKV_SRC + 3072 + n]); }
                    for (int i = gt; i < (NQKV - NQKV_SRC) * D / 8; i += NGT) ((v4u*)(W_QKV + (size_t)NQKV_SRC * D))[i] = (v4u){0u, 0u, 0u, 0u};
                } } }
        SEAM(pf);
        if (RUN(pf + 1)) { pg8::Gemm g{BIG, W_DN_(L), M, D, FF, FF}; pg8::StaticOrder S; S.init(M, D, G, bid);
            if (L == 0) { IDS(); shiftw_rows(W_QKV, NQKV, MODS_(2), SW_QKV, gw, NGW, lane); shiftw_rows(W_UP_(1), FF2, MODS_(3), SW_UP_(1), gw, NGW, lane); }
            { IDS(); pg8::Unit uu; for (int i = 0; S.next(i, uu); ++i) ffn_fixup(BIG, FIXA, FIXB, HALO, args.in[20] + (size_t)L * 3 * FF, args.in[21] + (size_t)L * FF, uu.pm, tid);
              asm volatile("s_waitcnt vmcnt(0)" ::: "memory"); __syncthreads(); }
            if (L == 0) { pg8::EpiResNorm<true> E{HBF, HBF, D, MODS_(1) + 2 * D, MODS, norm_g + (size_t)2 * D, MODS_(2) + D, XN, RS_(1)};
                pg8::gemm_phase<pg8::EpiResNorm<true>, pg8::StaticOrder, true, true>(lds, g, S, E); }
            else { pg8::EpiResFinal E{HBF, out, D, MODS_(3) + 2 * D, MODS, args.in[23], (unsigned*)(ws + WS_XBUF), (unsigned*)(ws + WS_PCNT)};
                pg8::gemm_phase<pg8::EpiResFinal, pg8::StaticOrder, false, true>(lds, g, S, E); }
            }
        if (L == 0) SEAM(pf + 1);
    }
__global__ void __launch_bounds__(NWAVES * 64, 2) mk_fwd(Args args) {
    extern __shared__ __attribute__((aligned(16))) unsigned char lds_raw[];
    cg::grid_group grid = cg::this_grid();
    LAS unsigned char* lds = (LAS unsigned char*)lds_raw;
    const int G = gridDim.x, bid = blockIdx.x;
    const int vcu = (G % 8 == 0) ? (bid % 8) * (G / 8) + bid / 8 : bid;
    const int NGW = G * NWAVES;
    const int lo = args.ph_lo, hi = args.ph_hi;
    if (lo < 0) grid.sync();
    volatile LAS unsigned* MISC = (volatile LAS unsigned*)(lds + RING_BYTES + 320);
    if (threadIdx.x < 32) MISC[threadIdx.x] = 0u;
    __syncthreads();
    const XcdBarrier bar = xcd_barrier_post((unsigned*)(ws + WS_BAR), MISC + 8);

    if (RUN(0)) { IDS();
        for (int it = bid; it < 4 * 48; it += G) {
            const int s = it / 48, cb = it % 48, n = 64 * cb + lane;
            const float* wp = ada_w + ((size_t)s * D + 128 * wave) * MODS + n; const float* c0 = cvec + 128 * wave; const float* c1 = cvec + D + 128 * wave;
            float a0 = 0.f, a1 = 0.f;
#pragma unroll 8
            for (int k = 0; k < 128; ++k) { const float wv = wp[(size_t)k * MODS]; const float x0 = c0[k], x1 = c1[k];
                a0 += x0 * __builtin_amdgcn_rcpf(1.0f + __expf(-x0)) * wv; a1 += x1 * __builtin_amdgcn_rcpf(1.0f + __expf(-x1)) * wv; }
            LAS float* red = (LAS float*)lds;
            red[(wave * 2 + 0) * 64 + lane] = a0; red[(wave * 2 + 1) * 64 + lane] = a1;
            __syncthreads();
            if (wave < 2) { float sm = 0.f;
#pragma unroll
                for (int w = 0; w < 8; ++w) sm += red[(w * 2 + wave) * 64 + lane];
                MOD[(size_t)(s * 2 + wave) * MODS + n] = sm + ada_b[s * MODS + n]; }
            asm volatile("s_waitcnt vmcnt(0)" ::: "memory");
            __syncthreads();
            if (s == 0 && tid == 0) {
                __builtin_amdgcn_fence(__ATOMIC_RELEASE, "agent"); asm volatile("s_waitcnt vmcnt(0)" ::: "memory");
                __hip_atomic_fetch_add((unsigned*)(ws + WS_BAR) + MOD0_FLAG, 1u, __ATOMIC_RELAXED, __HIP_MEMORY_SCOPE_AGENT); }
        }
        {
            constexpr int I_SQ = (D / 64) * (D / 32), I_UP = (D / 64) * (FF2 / 32);
            constexpr int NITEMS = 3 * I_SQ + I_UP;
            for (int it = gw; it < NITEMS; it += NGW) { int r = it;
                if (r < I_SQ) { transpose_item(args.in[5], D, D / 32, D, W_A, 0, scr, r, lane); continue; } r -= I_SQ;
                if (r < I_SQ) { transpose_item(args.in[14], D, D / 32, D, W_B, 0, scr, r, lane); continue; } r -= I_SQ;
                if (r < I_SQ) { transpose_item(args.in[15], D, D / 32, D, W_C_(0), 0, scr, r, lane); continue; } r -= I_SQ;
                transpose_item(args.in[19], FF2, FF2 / 32, D, W_UP_(0), 0, scr, r, lane, FF); }
            const int gt = gw * 64 + lane, NGT = NGW * 64;
            for (int i = gt; i < 3 * M / 4; i += NGT) ((f32x4*)RS_(0))[i] = (f32x4){0.f, 0.f, 0.f, 0.f};
        }
        { const int g = gw - (NGW - 64); if (g >= 0 && g < 64) s5_precompute(g, lane, args.in[6], args.in[7], args.in[8], args.in[9], args.in[10], args.in[11], args.in[12], LAM, BFm, CFm); }
    }
    if (RUN(1)) { IDS();
        if (tid == 0) { unsigned* fl = (unsigned*)(ws + WS_BAR) + MOD0_FLAG;
            for (unsigned sp = 0; sp < (1u << 22); ++sp) { if (__hip_atomic_load(fl, __ATOMIC_RELAXED, __HIP_MEMORY_SCOPE_AGENT) >= 48u) break; __builtin_amdgcn_s_sleep(2); }
            __builtin_amdgcn_fence(__ATOMIC_ACQUIRE, "agent"); asm volatile("s_waitcnt vmcnt(0)" ::: "memory"); }
        __syncthreads();
        norm_mod_phase(x_in, XN, norm_g, MODS_(0), gw, NGW, lane);
    }
    SEAM(1);

    layer_phases<0>(args, bar, lds, lds_raw, G, bid, vcu, NGW, lo, hi);
    layer_phases<1>(args, bar, lds, lds_raw, G, bid, vcu, NGW, lo, hi);
#undef RUN
#undef SEAM
#undef ws
#undef x_in
#undef cvec
#undef norm_g
#undef ada_w
#undef ada_b
#undef out
#undef hin
}

extern "C" void kernel_launch(void* const* d_in, const int* in_sizes, int n_in, void* d_out, int out_size, void* d_ws, size_t ws_size, hipStream_t stream) {
    static int grid = 0;
    if (grid == 0) {
        if (n_in != 24 || in_sizes[0] != M * D || out_size != M * D || ws_size < WS_END) { fprintf(stderr, "kernel_launch: unexpected shapes (n_in %d, in0 %d, out %d, ws %zu)\n", n_in, n_in > 0 ? in_sizes[0] : -1, out_size, ws_size); grid = -1; return; }
        int dev = 0, cus = 0, per_cu = 0;
        if (hipGetDevice(&dev) != hipSuccess || hipDeviceGetAttribute(&cus, hipDeviceAttributeMultiprocessorCount, dev) != hipSuccess) { grid = -1; return; }
        if (hipFuncSetAttribute((const void*)mk_fwd, hipFuncAttributeMaxDynamicSharedMemorySize, LDS_BYTES) != hipSuccess) { fprintf(stderr, "kernel_launch: hipFuncSetAttribute failed\n"); grid = -1; return; }
        if (hipOccupancyMaxActiveBlocksPerMultiprocessor(&per_cu, (const void*)mk_fwd, NWAVES * 64, LDS_BYTES) != hipSuccess || per_cu < 1) { fprintf(stderr, "kernel_launch: occupancy query says %d\n", per_cu); per_cu = 1; }
        (void)hipGetLastError();
        grid = cus * 1;
        if (grid != 256) { fprintf(stderr, "kernel_launch: %d CUs; this kernel is built for 256 (one workgroup per CU); nothing launched\n", grid); grid = -1; return; }
    }
    if (grid < 0) return;
    if (hipMemsetAsync((char*)d_ws + WS_BAR, 0, BAR_BYTES, stream) != hipSuccess) { fprintf(stderr, "kernel_launch: memset failed\n"); return; }
    Args a{};
    for (int i = 0; i < 24; ++i) a.in[i] = (const float*)d_in[i];
    a.out = (float*)d_out; a.ws = (unsigned char*)d_ws;
    void* kargs[] = {&a};
#if MK_PER_PHASE
    for (int k = 0; k < N_PHASES; ++k) { a.ph_lo = k; a.ph_hi = k + 1;
        hipError_t e = hipLaunchCooperativeKernel((const void*)mk_fwd, dim3(grid), dim3(NWAVES * 64), kargs, LDS_BYTES, stream);
        if (e != hipSuccess) { fprintf(stderr, "kernel_launch: launch %d failed: %s\n", k, hipGetErrorString(e)); break; } }
#else
    a.ph_lo = 0; a.ph_hi = N_PHASES;
    hipError_t e = hipLaunchCooperativeKernel((const void*)mk_fwd, dim3(grid), dim3(NWAVES * 64), kargs, LDS_BYTES, stream);
    if (e != hipSuccess) fprintf(stderr, "kernel_launch: cooperative launch failed: %s (grid %d)\n", hipGetErrorString(e), grid);
#endif
}
```
